# Optimizing an MI355X kernel written in HIP

```python
import math
import jax, jax.numpy as jnp
from jax import lax
import numpy as np

D_MODEL = 1024
BATCH = 8
SEQ = 4096
DEPTH = 2

N_MIXERS = 2
N_RWKV_LAYERS = (DEPTH + 1) // 2
N_DSA_LAYERS = DEPTH // 2
N_META = 16
D_FF = 2816
NORM_EPS = 1e-6
HEAD_DIM = 64
ROPE_DIM = HEAD_DIM // 4
ROPE_THETA = 500000.0
RWKV_HEADS = D_MODEL // HEAD_DIM
D_DECAY_LORA = 64
D_AAA_LORA = 64
D_GATE_LORA = 160
RWKV_LN_EPS = 64e-5
ATT_HEADS = D_MODEL // HEAD_DIM
ATT_KV_HEADS = 4
ATT_GROUP = ATT_HEADS // ATT_KV_HEADS
IDX_HEADS = 8
IDX_DIM = 64
TOPK_MAX = 256
Q_BLOCK = 128
ATT_Q_W = ATT_HEADS * HEAD_DIM
ATT_KV_W = ATT_KV_HEADS * HEAD_DIM
IDX_Q_W = IDX_HEADS * IDX_DIM
ATT_SPLITS = (ATT_Q_W, ATT_Q_W + ATT_KV_W, ATT_Q_W + 2 * ATT_KV_W,
              ATT_Q_W + 2 * ATT_KV_W + IDX_Q_W, ATT_Q_W + 2 * ATT_KV_W + IDX_Q_W + IDX_DIM)
ATT_IN_W = ATT_Q_W + 2 * ATT_KV_W + IDX_Q_W + IDX_DIM + IDX_HEADS

kernel_name = "hybrid_rwkv7_dsa_macaron"


def rms_norm(x, g, eps=NORM_EPS):
    xf = x.astype(jnp.float32)
    y = xf * lax.rsqrt(jnp.mean(xf * xf, axis=-1, keepdims=True) + eps)
    return y.astype(x.dtype) * g


def swiglu(h, w_in, w_out):
    gate, up = jnp.split(h @ w_in, 2, axis=-1)
    return (jax.nn.silu(gate) * up) @ w_out


def rope_tables(n_pos, dtype):
    inv = ROPE_THETA ** (-jnp.arange(0, ROPE_DIM, 2, dtype=jnp.float32) / ROPE_DIM)
    ang = jnp.arange(n_pos, dtype=jnp.float32)[:, None] * inv[None, :]
    return jnp.cos(ang).astype(dtype), jnp.sin(ang).astype(dtype)


def partial_rope(x, cos, sin):
    half = ROPE_DIM // 2
    x1 = x[..., :half]
    x2 = x[..., half:ROPE_DIM]
    c = cos[None, :, None, :]
    s = sin[None, :, None, :]
    return jnp.concatenate([x1 * c - x2 * s, x2 * c + x1 * s, x[..., ROPE_DIM:]], axis=-1)


def wkv7_scan(r, w, k, v, a, b):
    B, T, H, N = r.shape
    xs = tuple(jnp.moveaxis(t.astype(jnp.float32), 1, 0) for t in (r, w, k, v, a, b))

    def step(S, inp):
        r_t, w_t, k_t, v_t, a_t, b_t = inp
        sa = jnp.einsum("bhij,bhj->bhi", S, a_t)
        S = S * w_t[:, :, None, :] + sa[..., None] * b_t[:, :, None, :] + v_t[..., None] * k_t[:, :, None, :]
        y = jnp.einsum("bhij,bhj->bhi", S, r_t)
        return S, y

    S0 = jnp.zeros((B, H, N, N), jnp.float32)
    _, ys = lax.scan(step, S0, xs)
    return jnp.moveaxis(ys, 0, 1).astype(r.dtype)


def rwkv7_time_mix(h, mix, w_r, w_k, w_v, w_o, w0, w1, w2, a0, a1, a2, g1, g2,
                   k_k, k_a, r_k, lnx_g, lnx_b):
    B, T, D = h.shape
    H, N = RWKV_HEADS, HEAD_DIM
    xx = jnp.pad(h, ((0, 0), (1, 0), (0, 0)))[:, :-1] - h
    xm = h[None] + xx[None] * mix[:, None, None, :]
    xr, xw, xk, xv, xa, xg = xm[0], xm[1], xm[2], xm[3], xm[4], xm[5]
    r = xr @ w_r
    k = xk @ w_k
    v = xv @ w_v
    w_log = -jax.nn.softplus(-(w0 + jnp.tanh(xw @ w1) @ w2)) - 0.5
    a = jax.nn.sigmoid(a0 + (xa @ a1) @ a2)
    g = jax.nn.sigmoid(xg @ g1) @ g2
    kk = (k * k_k).reshape(B, T, H, N).astype(jnp.float32)
    kk = (kk / jnp.maximum(jnp.sqrt(jnp.sum(kk * kk, axis=-1, keepdims=True)), 1e-12)).astype(h.dtype)
    k = k * (1.0 + (a - 1.0) * k_a)
    decay = jnp.exp(-jnp.exp(w_log.astype(jnp.float32)))
    rh = r.reshape(B, T, H, N)
    kh = k.reshape(B, T, H, N)
    vh = v.reshape(B, T, H, N)
    ah = a.reshape(B, T, H, N)
    y = wkv7_scan(rh, decay.reshape(B, T, H, N), kh, vh, -kk, kk * ah)
    yf = y.astype(jnp.float32)
    mu = jnp.mean(yf, axis=-1, keepdims=True)
    var = jnp.mean((yf - mu) ** 2, axis=-1, keepdims=True)
    yn = ((yf - mu) * lax.rsqrt(var + RWKV_LN_EPS)).astype(h.dtype).reshape(B, T, D) * lnx_g + lnx_b
    bonus = (jnp.sum(rh * kh * r_k, axis=-1, keepdims=True) * vh).reshape(B, T, D)
    return ((yn + bonus) * g) @ w_o


def dsa_attention(h, w_in, q_g, k_g, w_o, cos, sin, topk):
    B, T, D = h.shape
    q, k, v, qi, ki, wi = jnp.split(h @ w_in, ATT_SPLITS, axis=-1)
    q = partial_rope(rms_norm(q.reshape(B, T, ATT_HEADS, HEAD_DIM), q_g), cos, sin)
    k = partial_rope(rms_norm(k.reshape(B, T, ATT_KV_HEADS, HEAD_DIM), k_g), cos, sin)
    v = v.reshape(B, T, ATT_KV_HEADS, HEAD_DIM)
    qi = partial_rope(qi.reshape(B, T, IDX_HEADS, IDX_DIM), cos, sin)
    ki = partial_rope(ki[:, :, None, :], cos, sin)[:, :, 0, :]
    wi = wi * (IDX_HEADS ** -0.5 * IDX_DIM ** -0.5)

    n_blk = -(-T // Q_BLOCK)
    pad = n_blk * Q_BLOCK - T

    def to_blocks(t):
        t = jnp.pad(t, [(0, 0), (0, pad)] + [(0, 0)] * (t.ndim - 2))
        return jnp.moveaxis(t.reshape((B, n_blk, Q_BLOCK) + t.shape[2:]), 1, 0)

    starts = jnp.arange(n_blk, dtype=jnp.int32) * Q_BLOCK
    kpos = jnp.arange(T, dtype=jnp.int32)
    scale = HEAD_DIM ** -0.5

    def block(args):
        qb, qib, wib, start = args
        qpos = start + jnp.arange(Q_BLOCK, dtype=jnp.int32)
        rel = jax.nn.relu(jnp.einsum("bqhd,bkd->bqhk", qib, ki))
        score = jnp.einsum("bqh,bqhk->bqk", wib, rel).astype(jnp.float32)
        causal = kpos[None, :] <= qpos[:, None]
        score = jnp.where(causal[None], score, -jnp.inf)
        _, idx = lax.top_k(score, topk)
        valid = idx <= qpos[None, :, None]
        kg = jax.vmap(lambda kb, ib: kb[ib])(k, idx)
        vg = jax.vmap(lambda vb, ib: vb[ib])(v, idx)
        qg = qb.reshape(B, Q_BLOCK, ATT_KV_HEADS, ATT_GROUP, HEAD_DIM)
        logits = jnp.einsum("bqgrd,bqkgd->bqgrk", qg, kg).astype(jnp.float32) * scale
        logits = jnp.where(valid[:, :, None, None, :], logits, -jnp.inf)
        p = jax.nn.softmax(logits, axis=-1).astype(v.dtype)
        o = jnp.einsum("bqgrk,bqkgd->bqgrd", p, vg)
        return o.reshape(B, Q_BLOCK, ATT_Q_W)

    out = lax.map(block, (to_blocks(q), to_blocks(qi), to_blocks(wi), starts))
    out = jnp.moveaxis(out, 0, 1).reshape(B, n_blk * Q_BLOCK, ATT_Q_W)[:, :T]
    return out @ w_o


def setup_inputs(seed: int = 0) -> dict:
    key = jax.random.key(seed)
    ks = jax.random.split(key, 32)
    f32 = jnp.float32

    def nrm(k, shape, scale):
        return jax.random.normal(k, shape, f32) * scale

    D = D_MODEL
    A = N_RWKV_LAYERS
    S = N_DSA_LAYERS
    return {
        "x": nrm(ks[0], (BATCH, SEQ, D), 1.0),
        "meta": nrm(ks[1], (N_META, D), 1.0),
        "norm_g": 1.0 + nrm(ks[2], (DEPTH, 3, D), 0.02),
        "ffn_w_in": nrm(ks[3], (DEPTH, 2, D, 2 * D_FF), D ** -0.5),
        "ffn_w_out": nrm(ks[4], (DEPTH, 2, D_FF, D), D_FF ** -0.5),
        "rk_mix": jax.random.uniform(ks[5], (A, 6, D), f32),
        "rk_w_r": nrm(ks[6], (A, D, D), D ** -0.5),
        "rk_w_k": nrm(ks[7], (A, D, D), D ** -0.5),
        "rk_w_v": nrm(ks[8], (A, D, D), D ** -0.5),
        "rk_w_o": nrm(ks[9], (A, D, D), D ** -0.5),
        "rk_w0": -0.6 + nrm(ks[10], (A, D), 0.3),
        "rk_w1": nrm(ks[11], (A, D, D_DECAY_LORA), D ** -0.5),
        "rk_w2": nrm(ks[12], (A, D_DECAY_LORA, D), 0.1 * D_DECAY_LORA ** -0.5),
        "rk_a0": nrm(ks[13], (A, D), 0.1),
        "rk_a1": nrm(ks[14], (A, D, D_AAA_LORA), D ** -0.5),
        "rk_a2": nrm(ks[15], (A, D_AAA_LORA, D), 0.1 * D_AAA_LORA ** -0.5),
        "rk_g1": nrm(ks[16], (A, D, D_GATE_LORA), D ** -0.5),
        "rk_g2": nrm(ks[17], (A, D_GATE_LORA, D), D_GATE_LORA ** -0.5),
        "rk_k_k": 0.85 + nrm(ks[18], (A, D), 0.05),
        "rk_k_a": 1.0 + nrm(ks[19], (A, D), 0.05),
        "rk_r_k": nrm(ks[20], (A, RWKV_HEADS, HEAD_DIM), 0.1),
        "rk_lnx_g": 1.0 + nrm(ks[21], (A, D), 0.02),
        "rk_lnx_b": nrm(ks[22], (A, D), 0.02),
        "at_w_in": nrm(ks[23], (S, D, ATT_IN_W), D ** -0.5),
        "at_q_g": 1.0 + nrm(ks[24], (S, HEAD_DIM), 0.02),
        "at_k_g": 1.0 + nrm(ks[25], (S, HEAD_DIM), 0.02),
        "at_w_o": nrm(ks[26], (S, ATT_Q_W, D), ATT_Q_W ** -0.5),
    }


def reference(x, meta, norm_g, ffn_w_in, ffn_w_out, rk_mix, rk_w_r, rk_w_k, rk_w_v, rk_w_o,
              rk_w0, rk_w1, rk_w2, rk_a0, rk_a1, rk_a2, rk_g1, rk_g2, rk_k_k, rk_k_a, rk_r_k,
              rk_lnx_g, rk_lnx_b, at_w_in, at_q_g, at_k_g, at_w_o):
    B, L, D = x.shape
    topk = min(TOPK_MAX, L // 4)
    h = jnp.concatenate([jnp.broadcast_to(meta.astype(x.dtype)[None], (B, N_META, D)), x], axis=1)
    T = h.shape[1]
    cos, sin = rope_tables(T, x.dtype)
    for i in range(DEPTH):
        g = norm_g[i]
        h = h + 0.5 * swiglu(rms_norm(h, g[0]), ffn_w_in[i, 0], ffn_w_out[i, 0])
        hn = rms_norm(h, g[1])
        j = i // N_MIXERS
        if i % N_MIXERS == 0:
            h = h + rwkv7_time_mix(hn, rk_mix[j], rk_w_r[j], rk_w_k[j], rk_w_v[j], rk_w_o[j],
                                   rk_w0[j], rk_w1[j], rk_w2[j], rk_a0[j], rk_a1[j], rk_a2[j],
                                   rk_g1[j], rk_g2[j], rk_k_k[j], rk_k_a[j], rk_r_k[j],
                                   rk_lnx_g[j], rk_lnx_b[j])
        else:
            h = h + dsa_attention(hn, at_w_in[j], at_q_g[j], at_k_g[j], at_w_o[j], cos, sin, topk)
        h = h + 0.5 * swiglu(rms_norm(h, g[2]), ffn_w_in[i, 1], ffn_w_out[i, 1])
    return h[:, N_META:]
```

```cpp
#include <hip/hip_runtime.h>
#include <hip/hip_cooperative_groups.h>
#include <cstdio>
namespace cg = cooperative_groups;
namespace pg8 {
#define PG8_LAS __attribute__((address_space(3)))
typedef unsigned short bf16_t;
typedef short bf16x8 __attribute__((ext_vector_type(8)));
typedef float f32x4 __attribute__((ext_vector_type(4)));
typedef unsigned u32x4 __attribute__((ext_vector_type(4)));
constexpr int BM = 256, BK = 64, HALF = 128, HTB = HALF * BK * 2  , STAGE_BYTES = 8 * HTB, NXCD = 8, WGM = 8;

__host__ __device__ __forceinline__ int lds_byte(int r, int c) { const int st = (r >> 4) * 2 + (c >> 5), rr = r & 15, cc = c & 31, ob = rr * 64 + cc * 2; return st * 1024 + (ob ^ (((ob >> 9) & 1) << 5)); }
__host__ __device__ __forceinline__ void stage_rc(int b, int& R, int& C) { const int st = b / 1024, sb = b % 1024, swz = sb ^ (((sb >> 9) & 1) << 5); R = (st >> 1) * 16 + swz / 64; C = (st & 1) * 32 + (swz % 64) / 2; }
__host__ __device__ __forceinline__ int perm32(int rho) { const int n = rho >> 4, i = rho & 15; return 8 * (i >> 2) + 4 * n + (i & 3); }

struct Unit { int pm, pn; };
struct Gemm { const bf16_t* A; const bf16_t* Bt; int M, N, K; };

struct StaticOrder {
    int nM, nN, nwg, G, c;
    __host__ __device__ void init(int M, int N, int G_, int c_) { nM = M / BM; nN = N / BM; nwg = nM * nN; G = G_; c = c_; }
    __host__ __device__ bool next(int i, Unit& u) const {
        const long L = (long)i * G + c; if (L >= nwg) return false;
        int wgid = (int)L; { const int q = nwg / NXCD, r = nwg % NXCD, xcd = wgid % NXCD, off = wgid / NXCD; wgid = (xcd < r ? xcd * (q + 1) : r * (q + 1) + (xcd - r) * q) + off; }
        const int nig = WGM * nN, gid = wgid / nig, fm = gid * WGM, gsz = (nM - fm) < WGM ? (nM - fm) : WGM;
        u.pm = fm + ((wgid % nig) % gsz); u.pn = (wgid % nig) / gsz; return true;
    }
    __device__ __forceinline__ void a_ready(const Unit&) const {}
    __device__ __forceinline__ void done(const Unit&) const {}
};
__device__ __forceinline__ unsigned cvt_pk_bf16(float lo, float hi) { unsigned r; asm volatile("v_cvt_pk_bf16_f32 %0, %1, %2" : "=v"(r) : "v"(lo), "v"(hi)); return r; }

template <class Epi, class Sched, bool STAMP = false>
__device__ __forceinline__ void gemm_phase(PG8_LAS unsigned char* lds, const Gemm g, const Sched& S, const Epi& E, unsigned long long* stamps) {
    int tid_l = threadIdx.x; asm volatile("" : "+v"(tid_l));
    const int tid = tid_l, wid = __builtin_amdgcn_readfirstlane(tid >> 6), lane = tid & 63, wr = wid >> 2, wc = wid & 3, fr = lane & 15, fq = lane >> 4;
    const int K = g.K, nt = K / BK;
    int ts_lo = 0, ts_hi = 0, nts = 0; const unsigned long long rt_entry = STAMP ? (unsigned long long)wall_clock64() : 0ull;
#define PG8_STAMP() do { if (STAMP && wid == 0 && nts < 64) { const unsigned long long _c = (unsigned long long)clock64(); \
        ts_lo = (lane == nts) ? (int)(unsigned)_c : ts_lo; ts_hi = (lane == nts) ? (int)(unsigned)(_c >> 32) : ts_hi; ++nts; } } while (0)
    PG8_STAMP();
    unsigned voffA[2], voffB[2];
#pragma unroll
    for (int i = 0; i < 2; ++i) { int R, C; stage_rc(tid * 16 + i * 8192, R, C); const int Rb = Epi::PERM ? ((R & ~31) + perm32(R & 31)) : R;
        voffA[i] = (unsigned)(R * K + C) * 2u; voffB[i] = (unsigned)(Rb * K + C) * 2u; }
    const size_t kstep = (size_t)(BK * 2);
    const size_t hstep = (size_t)HALF * K * 2;
    const size_t tstep = 2 * hstep;
    const unsigned ldsw = (unsigned)wid * 1024u;
    const int aoff = lds_byte(wr * 64 + fr, fq * 8), boff = lds_byte(wc * 32 + fr, fq * 8);
#define PG8_SA(b, h) (((b) * 2 + (h)) * HTB)
#define PG8_SB(b, h) ((4 + (b) * 2 + (h)) * HTB)
#define PG8_STAGE(bufoff, gbase, voff) do { _Pragma("unroll") for (int _i = 0; _i < 2; ++_i) \
        __builtin_amdgcn_global_load_lds((const unsigned*)((const char*)(gbase) + (voff)[_i]), (PG8_LAS unsigned*)(lds + (bufoff) + ldsw + _i * 8192), 16, 0, 0); } while (0)
#define PG8_LDA(dst, b, h) do { _Pragma("unroll") for (int m = 0; m < 4; ++m) _Pragma("unroll") for (int k = 0; k < 2; ++k) dst[m][k] = *(const PG8_LAS bf16x8*)(lds + PG8_SA(b, h) + aoff + m * 2048 + k * 1024); } while (0)
#define PG8_LDB(dst, b, h) do { _Pragma("unroll") for (int n = 0; n < 2; ++n) _Pragma("unroll") for (int k = 0; k < 2; ++k) dst[n][k] = *(const PG8_LAS bf16x8*)(lds + PG8_SB(b, h) + boff + n * 2048 + k * 1024); } while (0)
#define PG8_MMA(ai, bj, At, Bt) do { __builtin_amdgcn_s_setprio(1); _Pragma("unroll") for (int m = 0; m < 4; ++m) _Pragma("unroll") for (int n = 0; n < 2; ++n) _Pragma("unroll") for (int k = 0; k < 2; ++k) \
        acc[ai][bj][m][n] = __builtin_amdgcn_mfma_f32_16x16x32_bf16(Bt[n][k], At[m][k], acc[ai][bj][m][n], 0, 0, 0); __builtin_amdgcn_s_setprio(0); } while (0)
#define PG8_WAIT_V(n) asm volatile("s_waitcnt vmcnt(" #n ")" ::: "memory")
#define PG8_WAIT_L(n) asm volatile("s_waitcnt lgkmcnt(" #n ")" ::: "memory")
#define PG8_BAR __builtin_amdgcn_s_barrier()
#define PG8_SCHED __builtin_amdgcn_sched_barrier(0)
    Unit cur, nxt; int ui = 0;
    if (!S.next(0, cur)) return;
    f32x4 acc[2][2][4][2];
#pragma unroll
    for (int a = 0; a < 2; ++a)
#pragma unroll
        for (int b = 0; b < 2; ++b)
#pragma unroll
            for (int m = 0; m < 4; ++m)
#pragma unroll
                for (int n = 0; n < 2; ++n) acc[a][b][m][n] = (f32x4){0.f, 0.f, 0.f, 0.f};
    bf16x8 At[4][2], B0[2][2], B1[2][2];
    const char* cA = (const char*)g.A + (size_t)cur.pm * tstep; const char* cB = (const char*)g.Bt + (size_t)cur.pn * tstep;
    S.a_ready(cur);
    PG8_STAGE(PG8_SB(0, 0), cB, voffB); PG8_STAGE(PG8_SA(0, 0), cA, voffA); PG8_STAGE(PG8_SB(0, 1), cB + hstep, voffB); PG8_STAGE(PG8_SA(0, 1), cA + hstep, voffA);
    if (wr == 1) PG8_BAR;
    PG8_WAIT_V(4); PG8_BAR;
    PG8_STAGE(PG8_SB(1, 0), cB + kstep, voffB); PG8_STAGE(PG8_SA(1, 0), cA + kstep, voffA); PG8_STAGE(PG8_SB(1, 1), cB + hstep + kstep, voffB);
    PG8_WAIT_V(6); PG8_BAR;
    PG8_STAMP();
    for (;;) {
        const bool has_next = S.next(ui + 1, nxt);
        const char* nA = has_next ? (const char*)g.A + (size_t)nxt.pm * tstep : cA; const char* nB = has_next ? (const char*)g.Bt + (size_t)nxt.pn * tstep : cB;
        for (int t = 0; t < nt; t += 2) {
            const bool last = (t == nt - 2);
            const char* a1 = cA + (size_t)(t + 1) * kstep;
            const char* a2 = last ? nA : cA + (size_t)(t + 2) * kstep; const char* b2 = last ? nB : cB + (size_t)(t + 2) * kstep;
            const char* a3 = a2 + kstep; const char* b3 = b2 + kstep;
            if (last && has_next) S.a_ready(nxt);
            PG8_LDB(B0, 0, 0); PG8_SCHED; PG8_LDA(At, 0, 0); PG8_STAGE(PG8_SA(1, 1), a1 + hstep, voffA);
            PG8_WAIT_L(8); PG8_BAR; PG8_WAIT_L(0); PG8_MMA(0, 0, At, B0); PG8_BAR; PG8_SCHED;
            PG8_LDB(B1, 0, 1); PG8_STAGE(PG8_SB(0, 0), b2, voffB);
            PG8_BAR; PG8_WAIT_L(0); PG8_MMA(0, 1, At, B1); PG8_BAR;
            PG8_LDA(At, 0, 1); PG8_STAGE(PG8_SA(0, 0), a2, voffA);
            PG8_BAR; PG8_WAIT_L(0); PG8_MMA(1, 0, At, B0); PG8_BAR; PG8_SCHED;
            PG8_STAGE(PG8_SB(0, 1), b2 + hstep, voffB);
            PG8_WAIT_V(6); PG8_BAR; PG8_MMA(1, 1, At, B1); PG8_BAR;
            PG8_LDB(B0, 1, 0); PG8_SCHED; PG8_LDA(At, 1, 0); PG8_STAGE(PG8_SA(0, 1), a2 + hstep, voffA);
            PG8_WAIT_L(8); PG8_BAR; PG8_WAIT_L(0); PG8_MMA(0, 0, At, B0); PG8_BAR; PG8_SCHED;
            PG8_LDB(B1, 1, 1); PG8_STAGE(PG8_SB(1, 0), b3, voffB);
            PG8_BAR; PG8_WAIT_L(0); PG8_MMA(0, 1, At, B1); PG8_BAR;
            PG8_LDA(At, 1, 1); PG8_STAGE(PG8_SA(1, 0), a3, voffA);
            PG8_BAR; PG8_WAIT_L(0); PG8_MMA(1, 0, At, B0); PG8_BAR; PG8_SCHED;
            PG8_STAGE(PG8_SB(1, 1), b3 + hstep, voffB);
            PG8_WAIT_V(6); PG8_BAR; PG8_MMA(1, 1, At, B1); PG8_BAR;
        }
        PG8_STAMP();
        if constexpr (!Epi::AFTER_DRAIN) { E(acc, cur, wr, wc, fr, fq); S.done(cur); }
        PG8_STAMP();
        if (!has_next) break;
#pragma unroll
        for (int a = 0; a < 2; ++a)
#pragma unroll
            for (int b = 0; b < 2; ++b)
#pragma unroll
                for (int m = 0; m < 4; ++m)
#pragma unroll
                    for (int n = 0; n < 2; ++n) acc[a][b][m][n] = (f32x4){0.f, 0.f, 0.f, 0.f};
        cur = nxt; cA = nA; cB = nB; ++ui;
    }
    PG8_WAIT_V(0);
    if (wr == 0) PG8_BAR;
    PG8_BAR;
    if constexpr (Epi::AFTER_DRAIN) { E.fused(acc, cur, wr, wc, fr, fq, lds, wid, lane); S.done(cur); }
    PG8_STAMP();
    if (STAMP && wid == 0) { stamps[lane] = lane < nts ? (((unsigned long long)(unsigned)ts_hi << 32) | (unsigned)ts_lo) : 0ull;
        if (lane == 62) stamps[62] = rt_entry; if (lane == 63) stamps[63] = (unsigned long long)wall_clock64(); }
#undef PG8_STAMP
#undef PG8_SA
#undef PG8_SB
#undef PG8_STAGE
#undef PG8_LDA
#undef PG8_LDB
#undef PG8_MMA
#undef PG8_WAIT_V
#undef PG8_WAIT_L
#undef PG8_BAR
#undef PG8_SCHED
}
}

using pg8::bf16_t; using pg8::f32x4; using pg8::u32x4; using pg8::bf16x8;
typedef unsigned u32x2 __attribute__((ext_vector_type(2)));

constexpr int NB = 8, T = 4112, SEQ = 4096, NMETA = 16, D = 1024, FF = 2816;
constexpr int M = NB * T;
constexpr int MP = 33024;
constexpr int LDS_BYTES = 147456;
constexpr int PW = 2304;
#ifndef STOP_AFTER
#define STOP_AFTER 99
#endif

struct Params { const float* in[27]; float* out; unsigned char* ws; float inv[8]; };

constexpr size_t SZ_H = (size_t)MP * D * 4, SZ_B16 = (size_t)MP * D * 2;
constexpr size_t OFF_H = 0, OFF_WB = OFF_H + SZ_H, SZ_WB = (size_t)20 << 20, OFF_R = OFF_WB + SZ_WB;
constexpr size_t OFF_XN = OFF_R, OFF_ACT = OFF_R + SZ_B16;
constexpr size_t OFF_AP = OFF_R, OFF_E = OFF_R, OFF_ASIG = OFF_R + SZ_B16, OFF_RKV = OFF_R + 2 * SZ_B16;
constexpr size_t SZ_L1 = (size_t)MP * 256 * 2;
constexpr size_t OFF_HN = OFF_R, OFF_P = OFF_R + SZ_B16, OFF_TAB = OFF_P + (size_t)MP * PW * 2;
constexpr size_t WB_W1T = 0, WB_W2T = (size_t)5632 * 1024 * 2;
constexpr size_t WB_WPT = 0, WB_L2W = (size_t)3840 * 2048 * 2, WB_RWO = WB_L2W + 3 * (size_t)1024 * 256 * 2;
constexpr size_t WB_WIT = 0, WB_AWO = (size_t)PW * 1024 * 2;
static_assert(OFF_RKV + 3 * SZ_B16 <= ((size_t)512 << 20), "ws");
static_assert(OFF_ACT + (size_t)MP * FF * 2 <= ((size_t)512 << 20), "ws");
static_assert(WB_RWO + (size_t)1024 * 1024 * 2 <= SZ_WB, "wb");

__device__ __forceinline__ unsigned pk2(float a, float b) { return pg8::cvt_pk_bf16(a, b); }
__device__ __forceinline__ float bf_lo(unsigned u) { return __uint_as_float(u << 16); }
__device__ __forceinline__ float bf_hi(unsigned u) { return __uint_as_float(u & 0xffff0000u); }
__device__ __forceinline__ unsigned short f2h(float x) { _Float16 h = (_Float16)x; return __builtin_bit_cast(unsigned short, h); }
__device__ __forceinline__ float h2f(unsigned short u) { return (float)__builtin_bit_cast(_Float16, u); }
__device__ __forceinline__ void lds_wave_sync() { asm volatile("s_waitcnt lgkmcnt(0)" ::: "memory"); }
__device__ __forceinline__ float wave_sum(float v) {
#pragma unroll
    for (int o = 1; o < 64; o <<= 1) v += __shfl_xor(v, o);
    return v;
}
template <int CTRL> __device__ __forceinline__ float dppmov(float v) {
    return __builtin_bit_cast(float, __builtin_amdgcn_update_dpp(0, __builtin_bit_cast(int, v), CTRL, 0xF, 0xF, true));
}
__device__ __forceinline__ float row16_sum(float v) { v += dppmov<0xB1>(v); v += dppmov<0x4E>(v); v += dppmov<0x141>(v); v += dppmov<0x140>(v); return v; }
__device__ __forceinline__ float row16_max(float v) { v = fmaxf(v, dppmov<0xB1>(v)); v = fmaxf(v, dppmov<0x4E>(v)); v = fmaxf(v, dppmov<0x141>(v)); v = fmaxf(v, dppmov<0x140>(v)); return v; }
__device__ __forceinline__ float sigmoidf_(float x) { return 1.0f / (1.0f + __expf(-x)); }

__device__ __forceinline__ void tr_job(const float* W, int Ksrc, int Nsrc, int ldn, const float* kscale, int perm,
                                       bf16_t* WT, int ldk, int drow0, int dk0, int Npad, int Kpad, float* scr, int gw, int ngw, int lane) {
    const int nblk = Npad / 32, nitems = (Kpad / 64) * nblk;
    for (int it = gw; it < nitems; it += ngw) {
        const int kb = it / nblk, nb = it % nblk, k0 = 64 * kb, n0 = 32 * nb;
        int ns0 = n0;
        if (perm) { const int pn = n0 >> 8, w = n0 & 255; ns0 = (w < 128) ? (128 * pn + w) : (FF + 128 * pn + (w - 128)); }
#pragma unroll 8
        for (int i = 0; i < 32; ++i) {
            const int kk = 2 * i + (lane >> 5), k = k0 + kk, n = ns0 + (lane & 31);
            float v = 0.f;
            if (k < Ksrc && n < Nsrc) { v = W[(size_t)k * ldn + n]; if (kscale) v *= kscale[k]; }
            scr[kk * 33 + (lane & 31)] = v;
        }
        lds_wave_sync();
        const int c = lane & 7;
#pragma unroll
        for (int j = 0; j < 4; ++j) {
            const int n = (lane >> 3) + 8 * j; const float* s = scr + (8 * c) * 33 + n;
            u32x4 o; o.x = pk2(s[0 * 33], s[1 * 33]); o.y = pk2(s[2 * 33], s[3 * 33]); o.z = pk2(s[4 * 33], s[5 * 33]); o.w = pk2(s[6 * 33], s[7 * 33]);
            *(u32x4*)(WT + (size_t)(drow0 + n0 + n) * ldk + dk0 + k0 + 8 * c) = o;
        }
        lds_wave_sync();
    }
}

template <int MODE>
__device__ __forceinline__ void norm_phase(const Params& p, const float* g, float* H, bf16_t* OUT, int gw, int ngw, int lane) {
    constexpr int LDO = (MODE == 2) ? 2 * D : D;
    f32x4 gv[4];
#pragma unroll
    for (int j = 0; j < 4; ++j) gv[j] = *(const f32x4*)(g + 4 * (lane + 64 * j));
    for (int r = gw; r < MP; r += ngw) {
        bf16_t* orow = OUT + (size_t)r * LDO;
        if (r >= M) {
#pragma unroll
            for (int j = 0; j < 4; ++j) { *(u32x2*)(orow + 4 * (lane + 64 * j)) = (u32x2){0u, 0u}; if (MODE == 2) *(u32x2*)(orow + D + 4 * (lane + 64 * j)) = (u32x2){0u, 0u}; }
            continue;
        }
        const int b = r / T, t = r - b * T;
        const float* src;
        if (MODE == 1) src = (t < NMETA) ? (p.in[1] + (size_t)t * D) : (p.in[0] + ((size_t)b * SEQ + (t - NMETA)) * D);
        else src = H + (size_t)r * D;
        f32x4 v[4]; float ss = 0.f;
#pragma unroll
        for (int j = 0; j < 4; ++j) { v[j] = *(const f32x4*)(src + 4 * (lane + 64 * j)); ss += v[j].x * v[j].x + v[j].y * v[j].y + v[j].z * v[j].z + v[j].w * v[j].w; }
        if (MODE == 1) {
#pragma unroll
            for (int j = 0; j < 4; ++j) *(f32x4*)(H + (size_t)r * D + 4 * (lane + 64 * j)) = v[j];
        }
        const float rstd = 1.0f / sqrtf(wave_sum(ss) * (1.0f / D) + 1e-6f);
#pragma unroll
        for (int j = 0; j < 4; ++j) v[j] = v[j] * rstd * gv[j];
        if (MODE == 2) {
            f32x4 pv[4];
            if (t > 0) {
                const float* ps = H + (size_t)(r - 1) * D; float s2 = 0.f;
#pragma unroll
                for (int j = 0; j < 4; ++j) { pv[j] = *(const f32x4*)(ps + 4 * (lane + 64 * j)); s2 += pv[j].x * pv[j].x + pv[j].y * pv[j].y + pv[j].z * pv[j].z + pv[j].w * pv[j].w; }
                const float rp = 1.0f / sqrtf(wave_sum(s2) * (1.0f / D) + 1e-6f);
#pragma unroll
                for (int j = 0; j < 4; ++j) pv[j] = pv[j] * rp * gv[j];
            } else {
#pragma unroll
                for (int j = 0; j < 4; ++j) pv[j] = (f32x4){0.f, 0.f, 0.f, 0.f};
            }
#pragma unroll
            for (int j = 0; j < 4; ++j) { const f32x4 xx = pv[j] - v[j]; *(u32x2*)(orow + D + 4 * (lane + 64 * j)) = (u32x2){pk2(xx.x, xx.y), pk2(xx.z, xx.w)}; }
        }
#pragma unroll
        for (int j = 0; j < 4; ++j) *(u32x2*)(orow + 4 * (lane + 64 * j)) = (u32x2){pk2(v[j].x, v[j].y), pk2(v[j].z, v[j].w)};
    }
}

struct EpiSwiGLU {
    static constexpr bool PERM = true, AFTER_DRAIN = false;
    bf16_t* O;
    __device__ __forceinline__ void operator()(const f32x4 (&acc)[2][2][4][2], const pg8::Unit& u, int wr, int wc, int fr, int fq) const {
        const int row0 = u.pm * 256 + wr * 64 + fr, col0 = u.pn * 128 + wc * 32 + 8 * fq;
#pragma unroll
        for (int ai = 0; ai < 2; ++ai)
#pragma unroll
            for (int m = 0; m < 4; ++m) {
                bf16_t* rowp = O + (size_t)(row0 + ai * 128 + m * 16) * FF + col0;
                float o[8];
#pragma unroll
                for (int n = 0; n < 2; ++n)
#pragma unroll
                    for (int j = 0; j < 4; ++j) { const float gte = acc[ai][0][m][n][j], up = acc[ai][1][m][n][j]; o[4 * n + j] = gte / (1.0f + __expf(-gte)) * up; }
                u32x4 w; w.x = pk2(o[0], o[1]); w.y = pk2(o[2], o[3]); w.z = pk2(o[4], o[5]); w.w = pk2(o[6], o[7]);
                *(u32x4*)rowp = w;
            }
    }
};
template <bool FINAL> struct EpiResid {
    static constexpr bool PERM = false, AFTER_DRAIN = false;
    float* H; float scale; float* out;
    __device__ __forceinline__ void operator()(const f32x4 (&acc)[2][2][4][2], const pg8::Unit& u, int wr, int wc, int fr, int fq) const {
        const int row0 = u.pm * 256 + wr * 64 + fr, col0 = u.pn * 256 + wc * 32 + 4 * fq;
#pragma unroll
        for (int ai = 0; ai < 2; ++ai)
#pragma unroll
            for (int m = 0; m < 4; ++m) {
                const int row = row0 + ai * 128 + m * 16;
                if (row < M) {
                    float* hp = H + (size_t)row * D + col0;
                    const int b = row / T, t = row - b * T;
                    float* op = FINAL ? (out + ((size_t)b * SEQ + (t - NMETA)) * D + col0) : nullptr;
#pragma unroll
                    for (int bj = 0; bj < 2; ++bj)
#pragma unroll
                        for (int n = 0; n < 2; ++n) {
                            f32x4 hv = *(const f32x4*)(hp + bj * 128 + n * 16); hv = hv + acc[ai][bj][m][n] * scale;
                            if (FINAL) { if (t >= NMETA) *(f32x4*)(op + bj * 128 + n * 16) = hv; }
                            else *(f32x4*)(hp + bj * 128 + n * 16) = hv;
                        }
                }
            }
    }
};
template <int mode> struct EpiBf {
    static constexpr bool PERM = true, AFTER_DRAIN = false;
    bf16_t* O0; bf16_t* O1; const float* bias; int ldo;
    template <int ACT> __device__ __forceinline__ void body(const f32x4 (&acc)[2][2][4][2], bf16_t* base, int ld, int row0, int col0) const {
#pragma unroll
        for (int ai = 0; ai < 2; ++ai)
#pragma unroll
            for (int m = 0; m < 4; ++m)
#pragma unroll
                for (int bj = 0; bj < 2; ++bj) {
                    bf16_t* rowp = base + (size_t)(row0 + ai * 128 + m * 16) * ld + col0 + bj * 128;
                    f32x4 v0 = acc[ai][bj][m][0], v1 = acc[ai][bj][m][1];
                    if (mode >= 2) { v0 = v0 + *(const f32x4*)(bias + col0 + bj * 128); v1 = v1 + *(const f32x4*)(bias + col0 + bj * 128 + 4); }
#pragma unroll
                    for (int j = 0; j < 4; ++j) {
                        if (ACT == 1) { v0[j] = 1.0f - 2.0f / (__expf(2.0f * v0[j]) + 1.0f); v1[j] = 1.0f - 2.0f / (__expf(2.0f * v1[j]) + 1.0f); }
                        if (ACT == 2) { v0[j] = sigmoidf_(v0[j]); v1[j] = sigmoidf_(v1[j]); }
                        if (ACT == 3) { v0[j] = 0.6065306597f * sigmoidf_(v0[j]); v1[j] = 0.6065306597f * sigmoidf_(v1[j]); }
                    }
                    u32x4 w;
#ifdef PKRTZ
                    if (ACT == 3) { typedef _Float16 h2_ __attribute__((ext_vector_type(2))); h2_ q0 = __builtin_amdgcn_cvt_pkrtz(v0[0], v0[1]), q1 = __builtin_amdgcn_cvt_pkrtz(v0[2], v0[3]), q2 = __builtin_amdgcn_cvt_pkrtz(v1[0], v1[1]), q3 = __builtin_amdgcn_cvt_pkrtz(v1[2], v1[3]);
                        w.x = __builtin_bit_cast(unsigned, q0); w.y = __builtin_bit_cast(unsigned, q1); w.z = __builtin_bit_cast(unsigned, q2); w.w = __builtin_bit_cast(unsigned, q3); } else
#endif
                    if (ACT == 3) {
                        w.x = f2h(v0[0]) | ((unsigned)f2h(v0[1]) << 16); w.y = f2h(v0[2]) | ((unsigned)f2h(v0[3]) << 16);
                        w.z = f2h(v1[0]) | ((unsigned)f2h(v1[1]) << 16); w.w = f2h(v1[2]) | ((unsigned)f2h(v1[3]) << 16);
                    } else { w.x = pk2(v0[0], v0[1]); w.y = pk2(v0[2], v0[3]); w.z = pk2(v1[0], v1[1]); w.w = pk2(v1[2], v1[3]); }
                    *(u32x4*)rowp = w;
                }
    }
    __device__ __forceinline__ void operator()(const f32x4 (&acc)[2][2][4][2], const pg8::Unit& u, int wr, int wc, int fr, int fq) const {
        const int row0 = u.pm * 256 + wr * 64 + fr, cl = wc * 32 + 8 * fq;
        if (mode == 1) {
            if (u.pn < 12) body<0>(acc, O0 + (size_t)(u.pn >> 2) * ((size_t)MP * D), D, row0, (u.pn & 3) * 256 + cl);
            else if (u.pn == 12) body<1>(acc, O1, 256, row0, cl);
            else if (u.pn == 13) body<0>(acc, O1 + (size_t)MP * 256, 256, row0, cl);
            else body<2>(acc, O1 + (size_t)2 * MP * 256, 256, row0, cl);
        } else if (mode == 2) body<3>(acc, O0, ldo, row0, u.pn * 256 + cl);
        else if (mode == 3) body<2>(acc, O0, ldo, row0, u.pn * 256 + cl);
        else body<0>(acc, O0, ldo, row0, u.pn * 256 + cl);
    }
};

template <class Epi>
__device__ __forceinline__ void run_gemm(unsigned char* smem, const bf16_t* A, const bf16_t* Bt, int N, int K, const Epi E, int rot) {
    pg8::Gemm g; g.A = A; g.Bt = Bt; g.M = MP; g.N = N; g.K = K;
    pg8::StaticOrder S; S.init(MP, N, (int)gridDim.x, (int)((blockIdx.x + rot) % gridDim.x));
    pg8::gemm_phase<Epi, pg8::StaticOrder, false>((PG8_LAS unsigned char*)smem, g, S, E, nullptr);
    __syncthreads();
}

constexpr int SC_STEP = 356, SC_TC = 32;
__device__ __forceinline__ void scan_phase(const Params& p, unsigned char* ws, bf16_t* Y, unsigned char* smem) {
    float* buf = (float*)smem;
    float* ybuf = (float*)(smem + SC_TC * SC_STEP * 4);
    const bf16_t* Rr = (const bf16_t*)(ws + OFF_RKV); const bf16_t* Kr = Rr + (size_t)MP * D; const bf16_t* Vr = Kr + (size_t)MP * D;
    const bf16_t* As = (const bf16_t*)(ws + OFF_ASIG); const unsigned short* Eh = (const unsigned short*)(ws + OFF_E);
    const int tid = threadIdx.x, ts = tid >> 4, sub = tid & 15;
    constexpr int NCH = (T + SC_TC - 1) / SC_TC;
    for (int item = blockIdx.x; item < 256; item += gridDim.x) {
        const int b = item >> 5, h = (item >> 1) & 15, half = item & 1;
        const int cb = h * 64 + 4 * sub;
        const f32x4 kkc = *(const f32x4*)(p.in[18] + cb), kac = *(const f32x4*)(p.in[19] + cb), w0c = *(const f32x4*)(p.in[10] + cb), a0c = *(const f32x4*)(p.in[13] + cb);
        u32x2 pr, pk, pa, pe, pv;
        auto issue = [&](int c) {
            const int t = c * SC_TC + ts;
            pr = (u32x2){0u, 0u}; pk = pr; pa = pr; pe = pr; pv = pr;
            if (t < T) {
                const size_t ro = ((size_t)b * T + t) * D;
                pr = *(const u32x2*)(Rr + ro + cb); pk = *(const u32x2*)(Kr + ro + cb); pa = *(const u32x2*)(As + ro + cb); pe = *(const u32x2*)(Eh + ro + cb);
                if (sub < 8) pv = *(const u32x2*)(Vr + ro + h * 64 + half * 32 + 4 * sub);
            }
        };
        auto stage = [&]() {
            float* sp = buf + ts * SC_STEP;
            const f32x4 r4 = (f32x4){bf_lo(pr.x), bf_hi(pr.x), bf_lo(pr.y), bf_hi(pr.y)};
            const f32x4 k4 = (f32x4){bf_lo(pk.x), bf_hi(pk.x), bf_lo(pk.y), bf_hi(pk.y)};
            f32x4 a4 = (f32x4){bf_lo(pa.x), bf_hi(pa.x), bf_lo(pa.y), bf_hi(pa.y)} + a0c;
            a4.x = sigmoidf_(a4.x); a4.y = sigmoidf_(a4.y); a4.z = sigmoidf_(a4.z); a4.w = sigmoidf_(a4.w);
            f32x4 e4 = (f32x4){bf_lo(pe.x), bf_hi(pe.x), bf_lo(pe.y), bf_hi(pe.y)} + w0c;
            e4.x = 0.6065306597f * sigmoidf_(e4.x); e4.y = 0.6065306597f * sigmoidf_(e4.y); e4.z = 0.6065306597f * sigmoidf_(e4.z); e4.w = 0.6065306597f * sigmoidf_(e4.w);
            f32x4 kk = k4 * kkc;
            const float ss = row16_sum(kk.x * kk.x + kk.y * kk.y + kk.z * kk.z + kk.w * kk.w);
            const float inv = 1.0f / fmaxf(sqrtf(ss), 1e-12f);
            kk = kk * inv;
            const f32x4 kf = k4 * (1.0f + (a4 - 1.0f) * kac);
            f32x4 w; w.x = __expf(-e4.x); w.y = __expf(-e4.y); w.z = __expf(-e4.z); w.w = __expf(-e4.w);
            const f32x4 Bv = kk * a4, WR = w * r4;
            const float br = row16_sum(Bv.x * r4.x + Bv.y * r4.y + Bv.z * r4.z + Bv.w * r4.w);
            const float kr = row16_sum(kf.x * r4.x + kf.y * r4.y + kf.z * r4.z + kf.w * r4.w);
            *(f32x4*)(sp + 4 * sub) = -kk; *(f32x4*)(sp + 64 + 4 * sub) = WR; *(f32x4*)(sp + 128 + 4 * sub) = w; *(f32x4*)(sp + 192 + 4 * sub) = Bv; *(f32x4*)(sp + 256 + 4 * sub) = kf;
            if (sub < 8) *(f32x4*)(sp + 320 + 4 * sub) = (f32x4){bf_lo(pv.x), bf_hi(pv.x), bf_lo(pv.y), bf_hi(pv.y)};
            if (sub == 0) { sp[352] = br; sp[353] = kr; }
        };
        issue(0); stage();
        __syncthreads();
        float S0 = 0.f, S1 = 0.f, S2 = 0.f, S3 = 0.f;
        const int il = ts;
        for (int c = 0; c < NCH; ++c) {
            const int nst = (T - c * SC_TC) < SC_TC ? (T - c * SC_TC) : SC_TC;
            if (c + 1 < NCH) issue(c + 1);
#pragma unroll 2
            for (int s = 0; s < nst; ++s) {
                const float* sp = buf + s * SC_STEP;
                const f32x4 A4 = *(const f32x4*)(sp + 4 * sub), WR4 = *(const f32x4*)(sp + 64 + 4 * sub), W4 = *(const f32x4*)(sp + 128 + 4 * sub);
                const f32x4 B4 = *(const f32x4*)(sp + 192 + 4 * sub), K4 = *(const f32x4*)(sp + 256 + 4 * sub);
                const float vi = sp[320 + il], br = sp[352], kr = sp[353];
                float sa = S0 * A4.x + S1 * A4.y + S2 * A4.z + S3 * A4.w;
                float yp = S0 * WR4.x + S1 * WR4.y + S2 * WR4.z + S3 * WR4.w;
                sa = row16_sum(sa); yp = row16_sum(yp);
                S0 = S0 * W4.x + sa * B4.x + vi * K4.x; S1 = S1 * W4.y + sa * B4.y + vi * K4.y;
                S2 = S2 * W4.z + sa * B4.z + vi * K4.z; S3 = S3 * W4.w + sa * B4.w + vi * K4.w;
                const float y = yp + sa * br + vi * kr;
                if (sub == 0) ybuf[s * 32 + il] = y;
            }
            __syncthreads();
            {
                const int t = c * SC_TC + ts;
                if (t < T) { const float y0 = ybuf[ts * 32 + 2 * sub], y1 = ybuf[ts * 32 + 2 * sub + 1];
                    *(unsigned*)(Y + ((size_t)b * T + t) * D + h * 64 + half * 32 + 2 * sub) = pk2(y0, y1); }
            }
            if (c + 1 < NCH) stage();
            __syncthreads();
        }
    }
}

__device__ __forceinline__ void rwkv_post_phase(const Params& p, unsigned char* ws, bf16_t* Y, int gw, int ngw, int lane) {
    const bf16_t* Rr = (const bf16_t*)(ws + OFF_RKV); const bf16_t* Kr = Rr + (size_t)MP * D; const bf16_t* Vr = Kr + (size_t)MP * D;
    const bf16_t* As = (const bf16_t*)(ws + OFF_ASIG); const bf16_t* G = (const bf16_t*)(ws + OFF_E);
    const int grp = lane >> 4, sub = lane & 15;
    for (int w = gw; w < MP * 4; w += ngw) {
        const int row = w >> 2, q = w & 3, c0 = (q * 4 + grp) * 64 + 4 * sub;
        const size_t o = (size_t)row * D + c0;
        if (row >= M) { *(u32x2*)(Y + o) = (u32x2){0u, 0u}; continue; }
        const u32x2 uy = *(const u32x2*)(Y + o), ur = *(const u32x2*)(Rr + o), uk = *(const u32x2*)(Kr + o), uv = *(const u32x2*)(Vr + o), ua = *(const u32x2*)(As + o), ug = *(const u32x2*)(G + o);
        const f32x4 y = (f32x4){bf_lo(uy.x), bf_hi(uy.x), bf_lo(uy.y), bf_hi(uy.y)}, r = (f32x4){bf_lo(ur.x), bf_hi(ur.x), bf_lo(ur.y), bf_hi(ur.y)};
        const f32x4 k = (f32x4){bf_lo(uk.x), bf_hi(uk.x), bf_lo(uk.y), bf_hi(uk.y)}, v = (f32x4){bf_lo(uv.x), bf_hi(uv.x), bf_lo(uv.y), bf_hi(uv.y)};
        f32x4 a = (f32x4){bf_lo(ua.x), bf_hi(ua.x), bf_lo(ua.y), bf_hi(ua.y)} + *(const f32x4*)(p.in[13] + c0);
        a.x = sigmoidf_(a.x); a.y = sigmoidf_(a.y); a.z = sigmoidf_(a.z); a.w = sigmoidf_(a.w);
        const f32x4 g = (f32x4){bf_lo(ug.x), bf_hi(ug.x), bf_lo(ug.y), bf_hi(ug.y)};
        const f32x4 kac = *(const f32x4*)(p.in[19] + c0), rkc = *(const f32x4*)(p.in[20] + c0), lg = *(const f32x4*)(p.in[21] + c0), lb = *(const f32x4*)(p.in[22] + c0);
        const f32x4 kf = k * (1.0f + (a - 1.0f) * kac);
        const f32x4 t3 = r * kf * rkc;
        const float rk = row16_sum(t3.x + t3.y + t3.z + t3.w);
        const float mu = row16_sum(y.x + y.y + y.z + y.w) * (1.0f / 64.0f);
        const f32x4 dlt = y - mu;
        const float var = row16_sum(dlt.x * dlt.x + dlt.y * dlt.y + dlt.z * dlt.z + dlt.w * dlt.w) * (1.0f / 64.0f);
        const float rs = 1.0f / sqrtf(var + 64e-5f);
        const f32x4 z = ((dlt * rs) * lg + lb + v * rk) * g;
        *(u32x2*)(Y + o) = (u32x2){pk2(z.x, z.y), pk2(z.z, z.w)};
    }
}

__device__ __forceinline__ void rope_table_phase(const Params& p, float* TAB, int gtid, int ngt) {
    for (int i = gtid; i < T * 8; i += ngt) {
        const int t = i >> 3, k = i & 7;
        const float ang = (float)t * p.inv[k];
        double rev = (double)ang * 0.15915494309189535; rev -= rint(rev);
        const float rf = (float)rev;
        TAB[t * 16 + k] = __builtin_amdgcn_cosf(rf); TAB[t * 16 + 8 + k] = __builtin_amdgcn_sinf(rf);
    }
}
__device__ __forceinline__ void attn_post_phase(const Params& p, bf16_t* P, const float* TAB, int gw, int ngw, int lane) {
    const int grp = lane >> 4, sub = lane & 15;
    const f32x4 qg = *(const f32x4*)(p.in[24] + 4 * sub), kg = *(const f32x4*)(p.in[25] + 4 * sub);
    for (int w = gw; w < M * 8; w += ngw) {
        const int row = w >> 3; int q4 = w & 7; if (q4 >= 5) q4 += 1;
        const int u = 4 * q4 + grp;
        const int t = row % T;
        bf16_t* ptr = P + (size_t)row * PW + 64 * u + 4 * sub;
        const u32x2 raw = *(const u32x2*)ptr;
        f32x4 x = (f32x4){bf_lo(raw.x), bf_hi(raw.x), bf_lo(raw.y), bf_hi(raw.y)};
        const bool isq = u < 16, isk = (u >= 16) && (u < 20), dorope = (u < 20) || (u >= 24 && u <= 32);
        const float ss = row16_sum(x.x * x.x + x.y * x.y + x.z * x.z + x.w * x.w) * (1.0f / 64.0f);
        if (isq || isk) { const float rs = 1.0f / sqrtf(ss + 1e-6f); x = x * rs * (isq ? qg : kg); }
        f32x4 xp; xp.x = dppmov<0x4E>(x.x); xp.y = dppmov<0x4E>(x.y); xp.z = dppmov<0x4E>(x.z); xp.w = dppmov<0x4E>(x.w);
        if (dorope && sub < 4) {
            const float* tb = TAB + t * 16 + (sub & 1) * 4;
            const f32x4 c = *(const f32x4*)tb, s = *(const f32x4*)(tb + 8);
            x = (sub < 2) ? (x * c - xp * s) : (x * c + xp * s);
        }
        if (u == 33) { if (sub < 2) x = x * 0.04419417382f; }
        if (u < 34) *(u32x2*)ptr = (u32x2){pk2(x.x, x.y), pk2(x.z, x.w)};
    }
}

constexpr int AT_WAVE_LDS = 16448 + 512;
__device__ __forceinline__ void attn_main_phase(const bf16_t* P, bf16_t* AO, unsigned char* smem, int wave, int lane, int bid, int nblk) {
    float* sc = (float*)(smem + wave * AT_WAVE_LDS);
    unsigned short* idxl = (unsigned short*)(smem + wave * AT_WAVE_LDS + 16448);
    const int b = bid & 7, n15 = lane & 15, kq = lane >> 4;
    const float NEG_INF = -__builtin_huge_valf();
    for (int ug = (bid >> 3); ug < T / 8; ug += (nblk >> 3)) {
        const int t = ug * 8 + wave;
        const size_t row = (size_t)b * T + t;
        const bf16_t* prow = P + row * PW;
        const bf16_t* pb = P + (size_t)b * T * PW;
        int nsel;
        if (t >= 256) {
            nsel = 256;
            bf16x8 ia0 = (bf16x8){0, 0, 0, 0, 0, 0, 0, 0}, ia1 = ia0;
            if (n15 < 8) { ia0 = *(const bf16x8*)(prow + 1536 + n15 * 64 + kq * 8); ia1 = *(const bf16x8*)(prow + 1536 + n15 * 64 + 32 + kq * 8); }
            float w4[4] = {0.f, 0.f, 0.f, 0.f};
            if (kq < 2) { const u32x2 wr = *(const u32x2*)(prow + 2112 + kq * 4); w4[0] = bf_lo(wr.x); w4[1] = bf_hi(wr.x); w4[2] = bf_lo(wr.y); w4[3] = bf_hi(wr.y); }
            const int ntile = (t >> 4) + 1;
#pragma unroll 4
            for (int kt = 0; kt < ntile; ++kt) {
                const bf16_t* kb = pb + (size_t)(16 * kt + n15) * PW + 2048 + kq * 8;
                const bf16x8 b0 = *(const bf16x8*)kb, b1 = *(const bf16x8*)(kb + 32);
                f32x4 acc = (f32x4){0.f, 0.f, 0.f, 0.f};
                acc = __builtin_amdgcn_mfma_f32_16x16x32_bf16(ia0, b0, acc, 0, 0, 0);
                acc = __builtin_amdgcn_mfma_f32_16x16x32_bf16(ia1, b1, acc, 0, 0, 0);
                float ps = w4[0] * fmaxf(acc[0], 0.f) + w4[1] * fmaxf(acc[1], 0.f) + w4[2] * fmaxf(acc[2], 0.f) + w4[3] * fmaxf(acc[3], 0.f);
                ps += __shfl_xor(ps, 16);
                if (lane < 16) sc[16 * kt + lane] = ps;
            }
            lds_wave_sync();
            unsigned key[65];
#pragma unroll
            for (int r = 0; r < 65; ++r) {
                const int e = r * 64 + lane;
                unsigned uu = __float_as_uint(sc[e]);
                if (uu == 0x80000000u) uu = 0u;
                uu = (uu & 0x80000000u) ? ~uu : (uu | 0x80000000u);
                key[r] = (e <= t) ? uu : 0u;
            }
            unsigned Tk = 0u;
            for (int bit = 31; bit >= 0; --bit) {
                const unsigned cand = Tk | (1u << bit);
                int cnt = 0;
#pragma unroll
                for (int gi = 0; gi < 5; ++gi) {
                    if (gi * 832 <= t) {
#pragma unroll
                        for (int rr = 0; rr < 13; ++rr) cnt += __popcll(__ballot(key[gi * 13 + rr] >= cand));
                    }
                }
                if (cnt >= 256) Tk = cand;
            }
            int ngt = 0;
#pragma unroll
            for (int r = 0; r < 65; ++r) ngt += __popcll(__ballot(key[r] > Tk));
            const int need = 256 - ngt;
            lds_wave_sync();
            int pg = 0, pe = 0;
#pragma unroll
            for (int r = 0; r < 65; ++r) {
                const int e = r * 64 + lane;
                const bool gt = key[r] > Tk, eq = key[r] == Tk;
                const unsigned long long mg = __ballot(gt), me = __ballot(eq);
                const int og = pg + (int)__builtin_amdgcn_mbcnt_hi((unsigned)(mg >> 32), __builtin_amdgcn_mbcnt_lo((unsigned)mg, 0u));
                const int oe = pe + (int)__builtin_amdgcn_mbcnt_hi((unsigned)(me >> 32), __builtin_amdgcn_mbcnt_lo((unsigned)me, 0u));
                if (gt) idxl[og] = (unsigned short)e;
                if (eq && oe < need) idxl[ngt + oe] = (unsigned short)e;
                pg += __popcll(mg); pe += __popcll(me);
            }
        } else {
            nsel = t + 1;
#pragma unroll
            for (int j = 0; j < 4; ++j) { const int e = j * 64 + lane; idxl[e] = (unsigned short)(e < t ? e : t); }
        }
        lds_wave_sync();
        const int ntile = (nsel + 15) >> 4;
        const bf16x8 qa0 = *(const bf16x8*)(prow + n15 * 64 + kq * 8), qa1 = *(const bf16x8*)(prow + n15 * 64 + 32 + kq * 8);
        float* invl = (float*)(idxl + 256) - 0;
        f32x4 mx4 = (f32x4){NEG_INF, NEG_INF, NEG_INF, NEG_INF};
#pragma unroll 2
        for (int kt = 0; kt < ntile; ++kt) {
            const int j = 16 * kt + n15;
            const int krow = idxl[j];
            const bf16_t* kb = pb + (size_t)krow * PW + 1024 + kq * 8;
            f32x4 a0 = (f32x4){0.f, 0.f, 0.f, 0.f}, a1 = a0, a2 = a0, a3 = a0;
            a0 = __builtin_amdgcn_mfma_f32_16x16x32_bf16(qa0, *(const bf16x8*)(kb), a0, 0, 0, 0);
            a0 = __builtin_amdgcn_mfma_f32_16x16x32_bf16(qa1, *(const bf16x8*)(kb + 32), a0, 0, 0, 0);
            a1 = __builtin_amdgcn_mfma_f32_16x16x32_bf16(qa0, *(const bf16x8*)(kb + 64), a1, 0, 0, 0);
            a1 = __builtin_amdgcn_mfma_f32_16x16x32_bf16(qa1, *(const bf16x8*)(kb + 96), a1, 0, 0, 0);
            a2 = __builtin_amdgcn_mfma_f32_16x16x32_bf16(qa0, *(const bf16x8*)(kb + 128), a2, 0, 0, 0);
            a2 = __builtin_amdgcn_mfma_f32_16x16x32_bf16(qa1, *(const bf16x8*)(kb + 160), a2, 0, 0, 0);
            a3 = __builtin_amdgcn_mfma_f32_16x16x32_bf16(qa0, *(const bf16x8*)(kb + 192), a3, 0, 0, 0);
            a3 = __builtin_amdgcn_mfma_f32_16x16x32_bf16(qa1, *(const bf16x8*)(kb + 224), a3, 0, 0, 0);
            f32x4 sel = (kq == 0) ? a0 : ((kq == 1) ? a1 : ((kq == 2) ? a2 : a3));
#pragma unroll
            for (int r = 0; r < 4; ++r) { sel[r] = (j < nsel) ? sel[r] * 0.125f : NEG_INF; mx4[r] = fmaxf(mx4[r], sel[r]); }
            *(f32x4*)(sc + j * 16 + 4 * kq) = sel;
        }
#pragma unroll
        for (int r = 0; r < 4; ++r) mx4[r] = row16_max(mx4[r]);
        f32x4 sm4 = (f32x4){0.f, 0.f, 0.f, 0.f};
        for (int kt = 0; kt < ntile; ++kt) {
            float* pp = sc + (16 * kt + n15) * 16 + 4 * kq;
            f32x4 v = *(const f32x4*)pp;
#pragma unroll
            for (int r = 0; r < 4; ++r) { v[r] = __expf(v[r] - mx4[r]); sm4[r] += v[r]; }
            *(f32x4*)pp = v;
        }
#pragma unroll
        for (int r = 0; r < 4; ++r) sm4[r] = 1.0f / row16_sum(sm4[r]);
        invl = sc + 4096;
        if (n15 == 0) *(f32x4*)(invl + 4 * kq) = sm4;
        lds_wave_sync();
        const int kp = lane >> 5, dp = lane & 31;
        float o[4][4][2];
#pragma unroll
        for (int g = 0; g < 4; ++g)
#pragma unroll
            for (int hh = 0; hh < 4; ++hh) { o[g][hh][0] = 0.f; o[g][hh][1] = 0.f; }
#pragma unroll 2
        for (int jp = 0; jp < 8 * ntile; ++jp) {
            const int j = 2 * jp + kp;
            const int krow = idxl[j];
            const bf16_t* vb = pb + (size_t)krow * PW + 1280 + 2 * dp;
#pragma unroll
            for (int g = 0; g < 4; ++g) {
                const unsigned vv = *(const unsigned*)(vb + 64 * g);
                const float v0 = bf_lo(vv), v1 = bf_hi(vv);
                const f32x4 p4 = *(const f32x4*)(sc + j * 16 + 4 * g);
#pragma unroll
                for (int hh = 0; hh < 4; ++hh) { o[g][hh][0] += p4[hh] * v0; o[g][hh][1] += p4[hh] * v1; }
            }
        }
#pragma unroll
        for (int g = 0; g < 4; ++g) {
            const f32x4 iv = *(const f32x4*)(invl + 4 * g);
#pragma unroll
            for (int hh = 0; hh < 4; ++hh) {
                const float o0 = (o[g][hh][0] + __shfl_xor(o[g][hh][0], 32)) * iv[hh], o1 = (o[g][hh][1] + __shfl_xor(o[g][hh][1], 32)) * iv[hh];
                if (lane < 32) *(unsigned*)(AO + row * D + (4 * g + hh) * 64 + 2 * dp) = pk2(o0, o1);
            }
        }
        lds_wave_sync();
    }
}

struct Ctx { int tid, lane, wave, gw, ngw, bid, nblk; };
__device__ __forceinline__ Ctx mkctx() {
    int tid = threadIdx.x, bid = blockIdx.x, nb = gridDim.x;
    asm volatile("" : "+v"(tid)); asm volatile("" : "+s"(bid)); asm volatile("" : "+s"(nb));
    Ctx c; c.tid = tid; c.lane = tid & 63; c.wave = tid >> 6; c.bid = bid; c.nblk = nb; c.gw = bid * 8 + c.wave; c.ngw = nb * 8; return c;
}
template <class T_> __device__ __forceinline__ T_* launder(T_* ptr) { return ptr; }

#define PHASE_END() do { grid.sync(); ++phase; if (STOP_AFTER == phase) { dump_h(p, H); return; } } while (0)
__device__ __forceinline__ void dump_h(const Params& p, const float* H) {
    for (size_t i = (size_t)blockIdx.x * 512 + threadIdx.x; i < (size_t)NB * SEQ * D / 4; i += (size_t)gridDim.x * 512) {
        const size_t e = i * 4, orow = e / D, c = e % D, b_ = orow / SEQ, t_ = orow % SEQ; *(f32x4*)(p.out + e) = *(const f32x4*)(H + ((size_t)b_ * T + t_ + NMETA) * D + c); }
}

__global__ void __launch_bounds__(512, 2) fwd_mega(Params p) {
    extern __shared__ __attribute__((aligned(16))) unsigned char smem[];
    cg::grid_group grid = cg::this_grid();
    int phase = 0;
#define WS_ (launder(p.ws))
#define H_ ((float*)(WS_ + OFF_H))
#define WB_ (WS_ + OFF_WB)
    float* H = (float*)(p.ws + OFF_H);

#define FFN_BLOCK(LAYER, SUB, FI) do { \
        const float* ng = p.in[2] + (size_t)(LAYER) * 3 * D + (SUB) * D; \
        { Ctx c = mkctx(); float* scr = (float*)(smem + c.wave * 8448); \
          const float* w_in = p.in[3] + ((size_t)(LAYER) * 2 + (FI)) * (size_t)D * 2 * FF; \
          const float* w_out = p.in[4] + ((size_t)(LAYER) * 2 + (FI)) * (size_t)FF * D; \
          tr_job(w_in, D, 2 * FF, 2 * FF, nullptr, 1, (bf16_t*)(WB_ + WB_W1T), D, 0, 0, 2 * FF, D, scr, c.gw, c.ngw, c.lane); \
          tr_job(w_out, FF, D, D, nullptr, 0, (bf16_t*)(WB_ + WB_W2T), FF, 0, 0, D, FF, scr, c.gw, c.ngw, c.lane); \
          if ((LAYER) == 0 && (SUB) == 0) norm_phase<1>(p, ng, H_, (bf16_t*)(WS_ + OFF_XN), c.gw, c.ngw, c.lane); \
          else norm_phase<0>(p, ng, H_, (bf16_t*)(WS_ + OFF_XN), c.gw, c.ngw, c.lane); } \
        PHASE_END(); \
        { EpiSwiGLU E; E.O = (bf16_t*)(WS_ + OFF_ACT); run_gemm(smem, (const bf16_t*)(WS_ + OFF_XN), (const bf16_t*)(WB_ + WB_W1T), 2 * FF, D, E, 0); } \
        PHASE_END(); \
        { EpiResid<((LAYER) == 1 && (SUB) == 2)> E; E.H = H_; E.scale = 0.5f; E.out = p.out; run_gemm(smem, (const bf16_t*)(WS_ + OFF_ACT), (const bf16_t*)(WB_ + WB_W2T), D, FF, E, 0); } \
        PHASE_END(); } while (0)

    FFN_BLOCK(0, 0, 0);
#ifndef NO_RWKV
    {
        bf16_t* Y = (bf16_t*)p.out; bf16_t* L1 = (bf16_t*)((unsigned char*)p.out + SZ_B16);
        {
            Ctx c = mkctx(); float* scr = (float*)(smem + c.wave * 8448);
            bf16_t* WPT = (bf16_t*)(WB_ + WB_WPT); bf16_t* L2W = (bf16_t*)(WB_ + WB_L2W); bf16_t* WOT = (bf16_t*)(WB_ + WB_RWO);
            const float* mix = p.in[5];
            tr_job(p.in[6], D, D, D, nullptr, 0, WPT, 2 * D, 0, 0, D, D, scr, c.gw, c.ngw, c.lane);
            tr_job(p.in[6], D, D, D, mix + 0 * D, 0, WPT, 2 * D, 0, D, D, D, scr, c.gw, c.ngw, c.lane);
            tr_job(p.in[7], D, D, D, nullptr, 0, WPT, 2 * D, 1024, 0, D, D, scr, c.gw, c.ngw, c.lane);
            tr_job(p.in[7], D, D, D, mix + 2 * D, 0, WPT, 2 * D, 1024, D, D, D, scr, c.gw, c.ngw, c.lane);
            tr_job(p.in[8], D, D, D, nullptr, 0, WPT, 2 * D, 2048, 0, D, D, scr, c.gw, c.ngw, c.lane);
            tr_job(p.in[8], D, D, D, mix + 3 * D, 0, WPT, 2 * D, 2048, D, D, D, scr, c.gw, c.ngw, c.lane);
            tr_job(p.in[11], D, 64, 64, nullptr, 0, WPT, 2 * D, 3072, 0, 256, D, scr, c.gw, c.ngw, c.lane);
            tr_job(p.in[11], D, 64, 64, mix + 1 * D, 0, WPT, 2 * D, 3072, D, 256, D, scr, c.gw, c.ngw, c.lane);
            tr_job(p.in[14], D, 64, 64, nullptr, 0, WPT, 2 * D, 3328, 0, 256, D, scr, c.gw, c.ngw, c.lane);
            tr_job(p.in[14], D, 64, 64, mix + 4 * D, 0, WPT, 2 * D, 3328, D, 256, D, scr, c.gw, c.ngw, c.lane);
            tr_job(p.in[16], D, 160, 160, nullptr, 0, WPT, 2 * D, 3584, 0, 256, D, scr, c.gw, c.ngw, c.lane);
            tr_job(p.in[16], D, 160, 160, mix + 5 * D, 0, WPT, 2 * D, 3584, D, 256, D, scr, c.gw, c.ngw, c.lane);
            tr_job(p.in[12], 64, D, D, nullptr, 0, L2W, 256, 0, 0, D, 256, scr, c.gw, c.ngw, c.lane);
            tr_job(p.in[15], 64, D, D, nullptr, 0, L2W + (size_t)1024 * 256, 256, 0, 0, D, 256, scr, c.gw, c.ngw, c.lane);
            tr_job(p.in[17], 160, D, D, nullptr, 0, L2W + (size_t)2 * 1024 * 256, 256, 0, 0, D, 256, scr, c.gw, c.ngw, c.lane);
            tr_job(p.in[9], D, D, D, nullptr, 0, WOT, D, 0, 0, D, D, scr, c.gw, c.ngw, c.lane);
            norm_phase<2>(p, p.in[2] + D, H_, (bf16_t*)(WS_ + OFF_AP), c.gw, c.ngw, c.lane);
        }
        PHASE_END();
#ifndef NO_G1
        { EpiBf<1> E; E.O0 = (bf16_t*)(WS_ + OFF_RKV); E.O1 = L1; E.bias = nullptr; E.ldo = D; run_gemm(smem, (const bf16_t*)(WS_ + OFF_AP), (const bf16_t*)(WB_ + WB_WPT), 3840, 2 * D, E, 0); }
#endif
        PHASE_END();
#ifndef NO_G23
        { EpiBf<0> E; E.O0 = (bf16_t*)(WS_ + OFF_E); E.O1 = nullptr; E.bias = nullptr; E.ldo = D; run_gemm(smem, L1, (const bf16_t*)(WB_ + WB_L2W), D, 256, E, 0); }
        { EpiBf<0> E; E.O0 = (bf16_t*)(WS_ + OFF_ASIG); E.O1 = nullptr; E.bias = nullptr; E.ldo = D; run_gemm(smem, L1 + (size_t)MP * 256, (const bf16_t*)(WB_ + WB_L2W) + (size_t)1024 * 256, D, 256, E, 64); }
#endif
        PHASE_END();
#ifndef NO_SCAN
        scan_phase(p, WS_, Y, smem);
#endif
        PHASE_END();
        { EpiBf<0> E; E.O0 = (bf16_t*)(WS_ + OFF_E); E.O1 = nullptr; E.bias = nullptr; E.ldo = D; run_gemm(smem, L1 + (size_t)2 * MP * 256, (const bf16_t*)(WB_ + WB_L2W) + (size_t)2 * 1024 * 256, D, 256, E, 128); }
        PHASE_END();
#ifndef NO_RPOST
        { Ctx c = mkctx(); rwkv_post_phase(p, WS_, Y, c.gw, c.ngw, c.lane); }
#endif
        PHASE_END();
        { EpiResid<false> E; E.H = H_; E.scale = 1.0f; E.out = nullptr; run_gemm(smem, Y, (const bf16_t*)(WB_ + WB_RWO), D, D, E, 0); }
        PHASE_END();
    }
#endif
    FFN_BLOCK(0, 2, 1);
    FFN_BLOCK(1, 0, 0);
#ifndef NO_ATTN
    {
        {
            Ctx c = mkctx(); float* scr = (float*)(smem + c.wave * 8448);
            tr_job(p.in[23], D, 2120, 2120, nullptr, 0, (bf16_t*)(WB_ + WB_WIT), D, 0, 0, PW, D, scr, c.gw, c.ngw, c.lane);
            tr_job(p.in[26], D, D, D, nullptr, 0, (bf16_t*)(WB_ + WB_AWO), D, 0, 0, D, D, scr, c.gw, c.ngw, c.lane);
            rope_table_phase(p, (float*)(WS_ + OFF_TAB), c.bid * 512 + c.tid, c.nblk * 512);
            norm_phase<0>(p, p.in[2] + 3 * D + D, H_, (bf16_t*)(WS_ + OFF_HN), c.gw, c.ngw, c.lane);
        }
        PHASE_END();
        { EpiBf<0> E; E.O0 = (bf16_t*)(WS_ + OFF_P); E.O1 = nullptr; E.bias = nullptr; E.ldo = PW; run_gemm(smem, (const bf16_t*)(WS_ + OFF_HN), (const bf16_t*)(WB_ + WB_WIT), PW, D, E, 0); }
        PHASE_END();
#ifndef NO_APOST
        { Ctx c = mkctx(); attn_post_phase(p, (bf16_t*)(WS_ + OFF_P), (const float*)(WS_ + OFF_TAB), c.gw, c.ngw, c.lane); }
#endif
        PHASE_END();
#ifndef NO_AMAIN
        { Ctx c = mkctx(); attn_main_phase((const bf16_t*)(WS_ + OFF_P), (bf16_t*)(WS_ + OFF_HN), smem, c.wave, c.lane, c.bid, c.nblk); }
#endif
        PHASE_END();
        { EpiResid<false> E; E.H = H_; E.scale = 1.0f; E.out = nullptr; run_gemm(smem, (const bf16_t*)(WS_ + OFF_HN), (const bf16_t*)(WB_ + WB_AWO), D, D, E, 0); }
        PHASE_END();
    }
#endif
    FFN_BLOCK(1, 2, 1);
}

extern "C" void kernel_launch(void* const* d_in, const int* in_sizes, int n_in, void* d_out, int out_size, void* d_ws, size_t ws_size, hipStream_t stream) {
    static int grid_blocks = 0;
    if (!grid_blocks) {
        int dev = 0, cus = 0, per_cu = 0;
        (void)hipGetDevice(&dev);
        (void)hipDeviceGetAttribute(&cus, hipDeviceAttributeMultiprocessorCount, dev);
        if (hipFuncSetAttribute((const void*)fwd_mega, hipFuncAttributeMaxDynamicSharedMemorySize, LDS_BYTES) != hipSuccess) fprintf(stderr, "hipFuncSetAttribute failed\n");
        if (hipOccupancyMaxActiveBlocksPerMultiprocessor(&per_cu, (const void*)fwd_mega, 512, LDS_BYTES) != hipSuccess || per_cu < 1) { fprintf(stderr, "occupancy query: %d\n", per_cu); per_cu = 1; }
        (void)hipGetLastError();
        grid_blocks = cus;
        if (grid_blocks % 8) grid_blocks -= grid_blocks % 8;
        if (ws_size < ((size_t)512 << 20)) fprintf(stderr, "workspace too small: %zu\n", ws_size);
    }
    Params p{};
    for (int i = 0; i < 27; ++i) p.in[i] = (const float*)d_in[i];
    p.out = (float*)d_out; p.ws = (unsigned char*)d_ws;
    for (int i = 0; i < 8; ++i) p.inv[i] = (float)pow(500000.0, -(double)i / 8.0);
    void* args[] = {&p};
    hipError_t e = hipLaunchCooperativeKernel((const void*)fwd_mega, dim3(grid_blocks), dim3(512), args, LDS_BYTES, stream);
    if (e != hipSuccess) fprintf(stderr, "cooperative launch failed: %s (grid %d)\n", hipGetErrorString(e), grid_blocks);
}
```

```cpp
#include <hip/hip_runtime.h>
#include <hip/hip_cooperative_groups.h>
#include <cstdio>
namespace cg = cooperative_groups;
namespace pg8 {
#define PG8_LAS __attribute__((address_space(3)))
typedef unsigned short bf16_t;
typedef short bf16x8 __attribute__((ext_vector_type(8)));
typedef float f32x4 __attribute__((ext_vector_type(4)));
typedef unsigned u32x4 __attribute__((ext_vector_type(4)));
constexpr int BM = 256, BK = 64, HALF = 128, HTB = HALF * BK * 2  , STAGE_BYTES = 8 * HTB, NXCD = 8, WGM = 8;

__host__ __device__ __forceinline__ int lds_byte(int r, int c) { const int st = (r >> 4) * 2 + (c >> 5), rr = r & 15, cc = c & 31, ob = rr * 64 + cc * 2; return st * 1024 + (ob ^ (((ob >> 9) & 1) << 5)); }
__host__ __device__ __forceinline__ void stage_rc(int b, int& R, int& C) { const int st = b / 1024, sb = b % 1024, swz = sb ^ (((sb >> 9) & 1) << 5); R = (st >> 1) * 16 + swz / 64; C = (st & 1) * 32 + (swz % 64) / 2; }
__host__ __device__ __forceinline__ int perm32(int rho) { const int n = rho >> 4, i = rho & 15; return 8 * (i >> 2) + 4 * n + (i & 3); }

struct Unit { int pm, pn; };
struct Gemm { const bf16_t* A; const bf16_t* Bt; int M, N, K, ld; };

struct StaticOrder {
    int nM, nN, nwg, G, c;
    __host__ __device__ void init(int M, int N, int G_, int c_) { nM = M / BM; nN = N / BM; nwg = nM * nN; G = G_; c = c_; }
    __host__ __device__ bool next(int i, Unit& u) const {
        const long L = (long)i * G + c; if (L >= nwg) return false;
        int wgid = (int)L; { const int q = nwg / NXCD, r = nwg % NXCD, xcd = wgid % NXCD, off = wgid / NXCD; wgid = (xcd < r ? xcd * (q + 1) : r * (q + 1) + (xcd - r) * q) + off; }
        const int nig = WGM * nN, gid = wgid / nig, fm = gid * WGM, gsz = (nM - fm) < WGM ? (nM - fm) : WGM;
        u.pm = fm + ((wgid % nig) % gsz); u.pn = (wgid % nig) / gsz; return true;
    }
    __device__ __forceinline__ void a_ready(const Unit&) const {}
    __device__ __forceinline__ void done(const Unit&) const {}
    __device__ __forceinline__ size_t aoff(const Unit& u, size_t tstep) const { return (size_t)u.pm * tstep; }
    __device__ __forceinline__ size_t boff(const Unit& u, size_t tstep) const { return (size_t)u.pn * tstep; }
};
struct SplitKOrder {
    int ncol, nun, G, c;
    __device__ void init(int ncol_, int nslice, int G_, int c_) { ncol = ncol_; nun = ncol_ * nslice; G = G_; c = c_; }
    __device__ bool next(int i, Unit& u) const { const long L = (long)i * G + c; if (L >= nun) return false; u.pm = 0; u.pn = (int)L; return true; }
    __device__ __forceinline__ void a_ready(const Unit&) const {}
    __device__ __forceinline__ void done(const Unit&) const {}
    __device__ __forceinline__ size_t aoff(const Unit& u, size_t) const { return (size_t)(u.pn / ncol) * 512; }
    __device__ __forceinline__ size_t boff(const Unit& u, size_t tstep) const { return (size_t)(u.pn % ncol) * tstep + (size_t)(u.pn / ncol) * 512; }
};
__device__ __forceinline__ unsigned cvt_pk_bf16(float lo, float hi) { unsigned r; asm volatile("v_cvt_pk_bf16_f32 %0, %1, %2" : "=v"(r) : "v"(lo), "v"(hi)); return r; }

template <class Epi, class Sched, bool STAMP = false>
__device__ __forceinline__ void gemm_phase(PG8_LAS unsigned char* lds, const Gemm g, const Sched& S, const Epi& E, unsigned long long* stamps) {
    int tid_l = threadIdx.x; asm volatile("" : "+v"(tid_l));
    const int tid = tid_l, wid = __builtin_amdgcn_readfirstlane(tid >> 6), lane = tid & 63, wr = wid >> 2, wc = wid & 3, fr = lane & 15, fq = lane >> 4;
    const int K = g.K, nt = K / BK;
    int ts_lo = 0, ts_hi = 0, nts = 0; const unsigned long long rt_entry = STAMP ? (unsigned long long)wall_clock64() : 0ull;
#define PG8_STAMP() do { if (STAMP && wid == 0 && nts < 64) { const unsigned long long _c = (unsigned long long)clock64(); \
        ts_lo = (lane == nts) ? (int)(unsigned)_c : ts_lo; ts_hi = (lane == nts) ? (int)(unsigned)(_c >> 32) : ts_hi; ++nts; } } while (0)
    PG8_STAMP();
    unsigned voffA[2], voffB[2];
#pragma unroll
    for (int i = 0; i < 2; ++i) { int R, C; stage_rc(tid * 16 + i * 8192, R, C); const int Rb = Epi::PERM ? ((R & ~31) + perm32(R & 31)) : R;
        voffA[i] = (unsigned)(R * g.ld + C) * 2u; voffB[i] = (unsigned)(Rb * g.ld + C) * 2u; }
    const size_t kstep = (size_t)(BK * 2);
    const size_t hstep = (size_t)HALF * g.ld * 2;
    const size_t tstep = 2 * hstep;
    const unsigned ldsw = (unsigned)wid * 1024u;
    const int aoff = lds_byte(wr * 64 + fr, fq * 8), boff = lds_byte(wc * 32 + fr, fq * 8);
#define PG8_SA(b, h) (((b) * 2 + (h)) * HTB)
#define PG8_SB(b, h) ((4 + (b) * 2 + (h)) * HTB)
#define PG8_STAGE(bufoff, gbase, voff) do { _Pragma("unroll") for (int _i = 0; _i < 2; ++_i) \
        __builtin_amdgcn_global_load_lds((const unsigned*)((const char*)(gbase) + (voff)[_i]), (PG8_LAS unsigned*)(lds + (bufoff) + ldsw + _i * 8192), 16, 0, 0); } while (0)
#define PG8_LDA(dst, b, h) do { _Pragma("unroll") for (int m = 0; m < 4; ++m) _Pragma("unroll") for (int k = 0; k < 2; ++k) dst[m][k] = *(const PG8_LAS bf16x8*)(lds + PG8_SA(b, h) + aoff + m * 2048 + k * 1024); } while (0)
#define PG8_LDB(dst, b, h) do { _Pragma("unroll") for (int n = 0; n < 2; ++n) _Pragma("unroll") for (int k = 0; k < 2; ++k) dst[n][k] = *(const PG8_LAS bf16x8*)(lds + PG8_SB(b, h) + boff + n * 2048 + k * 1024); } while (0)
#define PG8_MMA(ai, bj, At, Bt) do { __builtin_amdgcn_s_setprio(1); _Pragma("unroll") for (int m = 0; m < 4; ++m) _Pragma("unroll") for (int n = 0; n < 2; ++n) _Pragma("unroll") for (int k = 0; k < 2; ++k) \
        acc[ai][bj][m][n] = __builtin_amdgcn_mfma_f32_16x16x32_bf16(Bt[n][k], At[m][k], acc[ai][bj][m][n], 0, 0, 0); __builtin_amdgcn_s_setprio(0); } while (0)
#define PG8_WAIT_V(n) asm volatile("s_waitcnt vmcnt(" #n ")" ::: "memory")
#define PG8_WAIT_L(n) asm volatile("s_waitcnt lgkmcnt(" #n ")" ::: "memory")
#define PG8_BAR __builtin_amdgcn_s_barrier()
#define PG8_SCHED __builtin_amdgcn_sched_barrier(0)
    Unit cur, nxt; int ui = 0;
    if (!S.next(0, cur)) return;
    f32x4 acc[2][2][4][2];
#pragma unroll
    for (int a = 0; a < 2; ++a)
#pragma unroll
        for (int b = 0; b < 2; ++b)
#pragma unroll
            for (int m = 0; m < 4; ++m)
#pragma unroll
                for (int n = 0; n < 2; ++n) acc[a][b][m][n] = (f32x4){0.f, 0.f, 0.f, 0.f};
    bf16x8 At[4][2], B0[2][2], B1[2][2];
    const char* cA = (const char*)g.A + S.aoff(cur, tstep); const char* cB = (const char*)g.Bt + S.boff(cur, tstep);
    S.a_ready(cur);
    PG8_STAGE(PG8_SB(0, 0), cB, voffB); PG8_STAGE(PG8_SA(0, 0), cA, voffA); PG8_STAGE(PG8_SB(0, 1), cB + hstep, voffB); PG8_STAGE(PG8_SA(0, 1), cA + hstep, voffA);
    if (wr == 1) PG8_BAR;
    PG8_WAIT_V(4); PG8_BAR;
    PG8_STAGE(PG8_SB(1, 0), cB + kstep, voffB); PG8_STAGE(PG8_SA(1, 0), cA + kstep, voffA); PG8_STAGE(PG8_SB(1, 1), cB + hstep + kstep, voffB);
    PG8_WAIT_V(6); PG8_BAR;
    PG8_STAMP();
    for (;;) {
        const bool has_next = S.next(ui + 1, nxt);
        const char* nA = has_next ? (const char*)g.A + S.aoff(nxt, tstep) : cA; const char* nB = has_next ? (const char*)g.Bt + S.boff(nxt, tstep) : cB;
        for (int t = 0; t < nt; t += 2) {
            const bool last = (t == nt - 2);
            const char* a1 = cA + (size_t)(t + 1) * kstep;
            const char* a2 = last ? nA : cA + (size_t)(t + 2) * kstep; const char* b2 = last ? nB : cB + (size_t)(t + 2) * kstep;
            const char* a3 = a2 + kstep; const char* b3 = b2 + kstep;
            if (last && has_next) S.a_ready(nxt);
            PG8_LDB(B0, 0, 0); PG8_SCHED; PG8_LDA(At, 0, 0); PG8_STAGE(PG8_SA(1, 1), a1 + hstep, voffA);
            PG8_WAIT_L(8); PG8_BAR; PG8_WAIT_L(0); PG8_MMA(0, 0, At, B0); PG8_BAR; PG8_SCHED;
            PG8_LDB(B1, 0, 1); PG8_STAGE(PG8_SB(0, 0), b2, voffB);
            PG8_BAR; PG8_WAIT_L(0); PG8_MMA(0, 1, At, B1); PG8_BAR;
            PG8_LDA(At, 0, 1); PG8_STAGE(PG8_SA(0, 0), a2, voffA);
            PG8_BAR; PG8_WAIT_L(0); PG8_MMA(1, 0, At, B0); PG8_BAR; PG8_SCHED;
            PG8_STAGE(PG8_SB(0, 1), b2 + hstep, voffB);
            PG8_WAIT_V(6); PG8_BAR; PG8_MMA(1, 1, At, B1); PG8_BAR;
            PG8_LDB(B0, 1, 0); PG8_SCHED; PG8_LDA(At, 1, 0); PG8_STAGE(PG8_SA(0, 1), a2 + hstep, voffA);
            PG8_WAIT_L(8); PG8_BAR; PG8_WAIT_L(0); PG8_MMA(0, 0, At, B0); PG8_BAR; PG8_SCHED;
            PG8_LDB(B1, 1, 1); PG8_STAGE(PG8_SB(1, 0), b3, voffB);
            PG8_BAR; PG8_WAIT_L(0); PG8_MMA(0, 1, At, B1); PG8_BAR;
            PG8_LDA(At, 1, 1); PG8_STAGE(PG8_SA(1, 0), a3, voffA);
            PG8_BAR; PG8_WAIT_L(0); PG8_MMA(1, 0, At, B0); PG8_BAR; PG8_SCHED;
            PG8_STAGE(PG8_SB(1, 1), b3 + hstep, voffB);
            PG8_WAIT_V(6); PG8_BAR; PG8_MMA(1, 1, At, B1); PG8_BAR;
        }
        PG8_STAMP();
        if constexpr (!Epi::AFTER_DRAIN) { E(acc, cur, wr, wc, fr, fq); S.done(cur); }
        PG8_STAMP();
        if (!has_next) break;
#pragma unroll
        for (int a = 0; a < 2; ++a)
#pragma unroll
            for (int b = 0; b < 2; ++b)
#pragma unroll
                for (int m = 0; m < 4; ++m)
#pragma unroll
                    for (int n = 0; n < 2; ++n) acc[a][b][m][n] = (f32x4){0.f, 0.f, 0.f, 0.f};
        cur = nxt; cA = nA; cB = nB; ++ui;
    }
    PG8_WAIT_V(0);
    if (wr == 0) PG8_BAR;
    PG8_BAR;
    if constexpr (Epi::AFTER_DRAIN) { E.fused(acc, cur, wr, wc, fr, fq, lds, wid, lane); S.done(cur); }
    PG8_STAMP();
    if (STAMP && wid == 0) { stamps[lane] = lane < nts ? (((unsigned long long)(unsigned)ts_hi << 32) | (unsigned)ts_lo) : 0ull;
        if (lane == 62) stamps[62] = rt_entry; if (lane == 63) stamps[63] = (unsigned long long)wall_clock64(); }
#undef PG8_STAMP
#undef PG8_SA
#undef PG8_SB
#undef PG8_STAGE
#undef PG8_LDA
#undef PG8_LDB
#undef PG8_MMA
#undef PG8_WAIT_V
#undef PG8_WAIT_L
#undef PG8_BAR
#undef PG8_SCHED
}
}
#define XB_TMO      128
#define XB_XCNT(j)  (256  + 64 * (j))
#define XB_XSUB(j)  (1280 + 64 * (j))
#define XB_XGEN(j)  (2304 + 64 * (j))
#define XB_TOP      3328
#define XB_TOPGEN   3392
#define XCD_BAR_WORDS 3456
#define XB_SPIN_CAP (1u << 18)
#ifndef LAS
#define LAS __attribute__((address_space(3)))
#endif

__device__ __forceinline__ unsigned xb_ld(unsigned* p)              { return __hip_atomic_load(p, __ATOMIC_RELAXED, __HIP_MEMORY_SCOPE_AGENT); }
__device__ __forceinline__ unsigned xb_add(unsigned* p, unsigned v) { return __hip_atomic_fetch_add(p, v, __ATOMIC_RELAXED, __HIP_MEMORY_SCOPE_AGENT); }
__device__ __forceinline__ unsigned xb_xcc_id() { return (unsigned)__builtin_amdgcn_s_getreg((3 << 11) | 20) & 0xFu; }
#define XB_SPIN(cond, bar) do { unsigned _sp = 0; while (cond) { __builtin_amdgcn_s_sleep(1); \
    if ((++_sp & 255u) == 0u) { if (xb_ld(&(bar)[XB_TMO])) break; if (_sp > XB_SPIN_CAP) { atomicAdd(&(bar)[XB_TMO], 1u); break; } } } } while (0)

struct XcdBarrier {
    unsigned* bar; unsigned x;
    volatile LAS unsigned* st;
};

__device__ __forceinline__ XcdBarrier xcd_barrier_post(unsigned* bar, volatile LAS unsigned* st) {
    XcdBarrier b; b.bar = bar; b.x = xb_xcc_id(); b.st = st;
    if (threadIdx.x == 0) (void)xb_add(&bar[XB_XCNT(b.x)], 1u);
    return b;
}
__device__ __forceinline__ void xcd_barrier_complete(unsigned* bar, unsigned x, unsigned& nloc, unsigned& nx) {
    const unsigned G = gridDim.x * gridDim.y * gridDim.z;
    unsigned sum, cnt, mine, sp = 0u;
    for (;;) {
        sum = 0u; cnt = 0u; mine = 0u;
#pragma unroll
        for (unsigned j = 0; j < 16; ++j) { const unsigned c = xb_ld(&bar[XB_XCNT(j)]); sum += c; cnt += (c > 0u) ? 1u : 0u; mine = (j == x) ? c : mine; }
        if (sum == G) break;
        __builtin_amdgcn_s_sleep(1);
        if ((++sp & 255u) == 0u) { if (xb_ld(&bar[XB_TMO])) break; if (sp > XB_SPIN_CAP) { atomicAdd(&bar[XB_TMO], 1u); break; } }
    }
    nloc = mine > 0u ? mine : 1u; nx = cnt > 0u ? cnt : 1u;
}

__device__ __forceinline__ void xcd_barrier(const XcdBarrier& b) {
    asm volatile("s_waitcnt vmcnt(0)" ::: "memory");
    __syncthreads();
    if (threadIdx.x == 0) {
        unsigned* bar = b.bar;
        __builtin_amdgcn_s_waitcnt(0);
        unsigned nloc = b.st[0], nx = b.st[1];
        if (nloc == 0u) { xcd_barrier_complete(bar, b.x, nloc, nx); b.st[0] = nloc; b.st[1] = nx; }
        const unsigned old = xb_add(&bar[XB_XSUB(b.x)], 1u);
        const unsigned gen = old / nloc;
        if (old + 1u == (gen + 1u) * nloc) {
            __builtin_amdgcn_fence(__ATOMIC_RELEASE, "agent");
            asm volatile("s_waitcnt vmcnt(0)" ::: "memory");
            const unsigned og = xb_add(&bar[XB_TOP], 1u);
            const unsigned tg = og / nx;
            if (og + 1u == (tg + 1u) * nx) xb_add(&bar[XB_TOPGEN], 1u);
            else XB_SPIN(xb_ld(&bar[XB_TOPGEN]) == tg, bar);
            __builtin_amdgcn_fence(__ATOMIC_ACQUIRE, "agent");
            xb_add(&bar[XB_XGEN(b.x)], 1u);
            asm volatile("s_waitcnt vmcnt(0)" ::: "memory");
        } else {
            XB_SPIN(xb_ld(&bar[XB_XGEN(b.x)]) == gen, bar);
            __builtin_amdgcn_fence(__ATOMIC_ACQUIRE, "agent");
            asm volatile("s_waitcnt vmcnt(0)" ::: "memory");
        }
    }
    __syncthreads();
}


using pg8::bf16_t; using pg8::f32x4; using pg8::u32x4; using pg8::bf16x8;
typedef unsigned u32x2 __attribute__((ext_vector_type(2)));

constexpr int NB = 8, T = 4112, SEQ = 4096, NMETA = 16, D = 1024, FF = 2816;
constexpr int M = NB * T;
constexpr int MP = 33024;
constexpr int MMAIN = 32768;
constexpr int LDS_BYTES = 147456;
constexpr int LDF = 2880;
constexpr int PW = 2304;
#ifndef NREP_NORM
#define NREP_NORM 1
#endif
#ifndef STOP_AFTER
#define STOP_AFTER 99
#endif

struct Params { const float* in[27]; float* out; unsigned char* ws; float inv[8]; };

constexpr size_t SZ_H = (size_t)MP * D * 4, SZ_B16 = (size_t)MP * D * 2;
constexpr size_t OFF_H = 0, OFF_WB = OFF_H + SZ_H, SZ_WB = (size_t)20 << 20, OFF_R = OFF_WB + SZ_WB;
constexpr size_t OFF_XN = OFF_R, OFF_ACT = OFF_R + SZ_B16;
constexpr size_t OFF_AP = OFF_R, OFF_E = OFF_R, OFF_ASIG = OFF_R + SZ_B16, OFF_RKV = OFF_R + 2 * SZ_B16;
constexpr size_t SZ_L1 = (size_t)MP * 256 * 2;
constexpr size_t OFF_BAR = (size_t)500 << 20;
constexpr size_t OFF_PART = (size_t)501 << 20;
constexpr size_t OFF_HN = OFF_R, OFF_P = OFF_R + SZ_B16, OFF_TAB = OFF_P + (size_t)MP * PW * 2;
constexpr size_t WB_W1T = 0, WB_W2T = (size_t)5632 * 1024 * 2;
static_assert(WB_W2T + (size_t)1024 * LDF * 2 <= ((size_t)20 << 20), "wb");
constexpr size_t WB_WPT = 0, WB_L2W = (size_t)3840 * 2048 * 2, WB_RWO = WB_L2W + 3 * (size_t)1024 * 256 * 2;
constexpr size_t WB_WIT = 0, WB_AWO = (size_t)PW * 1024 * 2;
static_assert(OFF_RKV + 3 * SZ_B16 <= ((size_t)512 << 20), "ws");
static_assert(OFF_ACT + (size_t)MP * LDF * 2 <= ((size_t)500 << 20), "ws");
static_assert(WB_RWO + (size_t)1024 * 1024 * 2 <= SZ_WB, "wb");

__device__ __forceinline__ unsigned pk2(float a, float b) { return pg8::cvt_pk_bf16(a, b); }
__device__ __forceinline__ float bf_lo(unsigned u) { return __uint_as_float(u << 16); }
__device__ __forceinline__ float bf_hi(unsigned u) { return __uint_as_float(u & 0xffff0000u); }
__device__ __forceinline__ unsigned short f2h(float x) { _Float16 h = (_Float16)x; return __builtin_bit_cast(unsigned short, h); }
__device__ __forceinline__ float h2f(unsigned short u) { return (float)__builtin_bit_cast(_Float16, u); }
__device__ __forceinline__ void lds_wave_sync() { asm volatile("s_waitcnt lgkmcnt(0)" ::: "memory"); }
__device__ __forceinline__ float wave_sum(float v) {
#pragma unroll
    for (int o = 1; o < 64; o <<= 1) v += __shfl_xor(v, o);
    return v;
}
template <int CTRL> __device__ __forceinline__ float dppmov(float v) {
    return __builtin_bit_cast(float, __builtin_amdgcn_update_dpp(0, __builtin_bit_cast(int, v), CTRL, 0xF, 0xF, true));
}
__device__ __forceinline__ float row16_sum(float v) { v += dppmov<0xB1>(v); v += dppmov<0x4E>(v); v += dppmov<0x141>(v); v += dppmov<0x140>(v); return v; }
__device__ __forceinline__ float row16_max(float v) { v = fmaxf(v, dppmov<0xB1>(v)); v = fmaxf(v, dppmov<0x4E>(v)); v = fmaxf(v, dppmov<0x141>(v)); v = fmaxf(v, dppmov<0x140>(v)); return v; }
__device__ __forceinline__ float sigmoidf_(float x) { return 1.0f / (1.0f + __expf(-x)); }

__device__ __forceinline__ void tr_job(const float* W, int Ksrc, int Nsrc, int ldn, const float* kscale, int perm,
                                       bf16_t* WT, int ldk, int drow0, int dk0, int Npad, int Kpad, float* scr, int gw, int ngw, int lane, int& rot) {
    const int nblk = Npad / 32, nitems = (Kpad / 64) * nblk;
    const int first = (gw >= rot) ? (gw - rot) : (gw + ngw - rot);
    rot = (rot + nitems) % ngw;
    for (int it = first; it < nitems; it += ngw) {
        const int kb = it / nblk, nb = it % nblk, k0 = 64 * kb, n0 = 32 * nb;
        int ns0 = n0;
        if (perm) { const int pn = n0 >> 8, w = n0 & 255; ns0 = (w < 128) ? (128 * pn + w) : (FF + 128 * pn + (w - 128)); }
#pragma unroll 16
        for (int i = 0; i < 32; ++i) {
            const int kk = 2 * i + (lane >> 5), k = k0 + kk, n = ns0 + (lane & 31);
            float v = 0.f;
            if (k < Ksrc && n < Nsrc) { v = W[(size_t)k * ldn + n]; if (kscale) v *= kscale[k]; }
            scr[kk * 33 + (lane & 31)] = v;
        }
        lds_wave_sync();
        const int c = lane & 7;
#pragma unroll
        for (int j = 0; j < 4; ++j) {
            const int n = (lane >> 3) + 8 * j; const float* s = scr + (8 * c) * 33 + n;
            u32x4 o; o.x = pk2(s[0 * 33], s[1 * 33]); o.y = pk2(s[2 * 33], s[3 * 33]); o.z = pk2(s[4 * 33], s[5 * 33]); o.w = pk2(s[6 * 33], s[7 * 33]);
            *(u32x4*)(WT + (size_t)(drow0 + n0 + n) * ldk + dk0 + k0 + 8 * c) = o;
        }
        lds_wave_sync();
    }
}

template <int MODE>
__device__ __forceinline__ void norm_phase(const Params& p, const float* g, float* H, bf16_t* OUT, int gw, int ngw, int lane, const float* PART = nullptr, int ns = 0) {
    constexpr int LDO = (MODE == 2) ? 2 * D : D;
    constexpr int NR = (MODE == 2) ? 2 : 4;
    f32x4 gv[4];
#pragma unroll
    for (int j = 0; j < 4; ++j) gv[j] = *(const f32x4*)(g + 4 * (lane + 64 * j));
    for (int r0 = gw; r0 < MP; r0 += NR * ngw) {
        f32x4 v[NR][4], pv[NR][4];
        int rr[NR], tt[NR];
#pragma unroll
        for (int q = 0; q < NR; ++q) {
            const int r = r0 + q * ngw; rr[q] = r;
            const int rc = (r < M) ? r : 0;
            const int b = rc / T, t = rc - b * T; tt[q] = t;
            const float* src;
            if (MODE == 1) src = (t < NMETA) ? (p.in[1] + (size_t)t * D) : (p.in[0] + ((size_t)b * SEQ + (t - NMETA)) * D);
            else src = H + (size_t)rc * D;
#pragma unroll
            for (int j = 0; j < 4; ++j) v[q][j] = *(const f32x4*)(src + 4 * (lane + 64 * j));
            if (MODE == 0 && ns > 0 && r >= MMAIN && r < M) {
                for (int s = 0; s < ns; ++s)
#pragma unroll
                    for (int j = 0; j < 4; ++j) v[q][j] = v[q][j] + *(const f32x4*)(PART + ((size_t)s * (M - MMAIN) + (r - MMAIN)) * D + 4 * (lane + 64 * j));
#pragma unroll
                for (int j = 0; j < 4; ++j) *(f32x4*)(H + (size_t)r * D + 4 * (lane + 64 * j)) = v[q][j];
            }
            if (MODE == 2) {
                const float* ps = H + (size_t)(rc > 0 ? rc - 1 : 0) * D;
#pragma unroll
                for (int j = 0; j < 4; ++j) pv[q][j] = *(const f32x4*)(ps + 4 * (lane + 64 * j));
            }
        }
#pragma unroll
        for (int q = 0; q < NR; ++q) {
            const int r = rr[q];
            if (r >= MP) continue;
            bf16_t* orow = OUT + (size_t)r * LDO;
            if (r >= M) {
#pragma unroll
                for (int j = 0; j < 4; ++j) { *(u32x2*)(orow + 4 * (lane + 64 * j)) = (u32x2){0u, 0u}; if (MODE == 2) *(u32x2*)(orow + D + 4 * (lane + 64 * j)) = (u32x2){0u, 0u}; }
                continue;
            }
            float ss = 0.f;
#pragma unroll
            for (int j = 0; j < 4; ++j) ss += v[q][j].x * v[q][j].x + v[q][j].y * v[q][j].y + v[q][j].z * v[q][j].z + v[q][j].w * v[q][j].w;
            if (MODE == 1) {
#pragma unroll
                for (int j = 0; j < 4; ++j) *(f32x4*)(H + (size_t)r * D + 4 * (lane + 64 * j)) = v[q][j];
            }
            const float rstd = 1.0f / sqrtf(wave_sum(ss) * (1.0f / D) + 1e-6f);
#pragma unroll
            for (int j = 0; j < 4; ++j) v[q][j] = v[q][j] * rstd * gv[j];
            if (MODE == 2) {
                if (tt[q] > 0) {
                    float s2 = 0.f;
#pragma unroll
                    for (int j = 0; j < 4; ++j) s2 += pv[q][j].x * pv[q][j].x + pv[q][j].y * pv[q][j].y + pv[q][j].z * pv[q][j].z + pv[q][j].w * pv[q][j].w;
                    const float rp = 1.0f / sqrtf(wave_sum(s2) * (1.0f / D) + 1e-6f);
#pragma unroll
                    for (int j = 0; j < 4; ++j) pv[q][j] = pv[q][j] * rp * gv[j];
                } else {
#pragma unroll
                    for (int j = 0; j < 4; ++j) pv[q][j] = (f32x4){0.f, 0.f, 0.f, 0.f};
                }
#pragma unroll
                for (int j = 0; j < 4; ++j) { const f32x4 xx = pv[q][j] - v[q][j]; *(u32x2*)(orow + D + 4 * (lane + 64 * j)) = (u32x2){pk2(xx.x, xx.y), pk2(xx.z, xx.w)}; }
            }
#pragma unroll
            for (int j = 0; j < 4; ++j) *(u32x2*)(orow + 4 * (lane + 64 * j)) = (u32x2){pk2(v[q][j].x, v[q][j].y), pk2(v[q][j].z, v[q][j].w)};
        }
    }
}

struct EpiSwiGLU {
    static constexpr bool PERM = true, AFTER_DRAIN = false;
    bf16_t* O;
    __device__ __forceinline__ void operator()(const f32x4 (&acc)[2][2][4][2], const pg8::Unit& u, int wr, int wc, int fr, int fq) const {
        const int row0 = u.pm * 256 + wr * 64 + fr, col0 = u.pn * 128 + wc * 32 + 8 * fq;
#pragma unroll
        for (int ai = 0; ai < 2; ++ai)
#pragma unroll
            for (int m = 0; m < 4; ++m) {
                bf16_t* rowp = O + (size_t)(row0 + ai * 128 + m * 16) * LDF + col0;
                float o[8];
#pragma unroll
                for (int n = 0; n < 2; ++n)
#pragma unroll
                    for (int j = 0; j < 4; ++j) { const float gte = acc[ai][0][m][n][j], up = acc[ai][1][m][n][j]; o[4 * n + j] = gte * __builtin_amdgcn_rcpf(1.0f + __expf(-gte)) * up; }
                u32x4 w; w.x = pk2(o[0], o[1]); w.y = pk2(o[2], o[3]); w.z = pk2(o[4], o[5]); w.w = pk2(o[6], o[7]);
                *(u32x4*)rowp = w;
            }
    }
};
template <bool FINAL> struct EpiResid {
    static constexpr bool PERM = false, AFTER_DRAIN = false;
    float* H; float scale; float* out;
    __device__ __forceinline__ void operator()(const f32x4 (&acc)[2][2][4][2], const pg8::Unit& u, int wr, int wc, int fr, int fq) const {
        const int row0 = u.pm * 256 + wr * 64 + fr, col0 = u.pn * 256 + wc * 32 + 4 * fq;
#pragma unroll
        for (int ai = 0; ai < 2; ++ai)
#pragma unroll
            for (int m = 0; m < 4; ++m) {
                const int row = row0 + ai * 128 + m * 16;
                if (row < M) {
                    float* hp = H + (size_t)row * D + col0;
                    const int b = row / T, t = row - b * T;
                    float* op = FINAL ? (out + ((size_t)b * SEQ + (t - NMETA)) * D + col0) : nullptr;
#pragma unroll
                    for (int bj = 0; bj < 2; ++bj)
#pragma unroll
                        for (int n = 0; n < 2; ++n) {
                            f32x4 hv = *(const f32x4*)(hp + bj * 128 + n * 16); hv = hv + acc[ai][bj][m][n] * scale;
                            if (FINAL) { if (t >= NMETA) *(f32x4*)(op + bj * 128 + n * 16) = hv; }
                            else *(f32x4*)(hp + bj * 128 + n * 16) = hv;
                        }
                }
            }
    }
};
template <int mode> struct EpiBf {
    static constexpr bool PERM = true, AFTER_DRAIN = false;
    bf16_t* O0; bf16_t* O1; const float* bias; int ldo;
    template <int ACT> __device__ __forceinline__ void body(const f32x4 (&acc)[2][2][4][2], bf16_t* base, int ld, int row0, int col0) const {
#pragma unroll
        for (int ai = 0; ai < 2; ++ai)
#pragma unroll
            for (int m = 0; m < 4; ++m)
#pragma unroll
                for (int bj = 0; bj < 2; ++bj) {
                    bf16_t* rowp = base + (size_t)(row0 + ai * 128 + m * 16) * ld + col0 + bj * 128;
                    f32x4 v0 = acc[ai][bj][m][0] + (f32x4){0.f, 0.f, 0.f, 0.f}, v1 = acc[ai][bj][m][1] + (f32x4){0.f, 0.f, 0.f, 0.f};
                    if (mode >= 2) { v0 = v0 + *(const f32x4*)(bias + col0 + bj * 128); v1 = v1 + *(const f32x4*)(bias + col0 + bj * 128 + 4); }
#pragma unroll
                    for (int j = 0; j < 4; ++j) {
                        if (ACT == 1) { v0[j] = 1.0f - 2.0f / (__expf(2.0f * v0[j]) + 1.0f); v1[j] = 1.0f - 2.0f / (__expf(2.0f * v1[j]) + 1.0f); }
                        if (ACT == 2) { v0[j] = sigmoidf_(v0[j]); v1[j] = sigmoidf_(v1[j]); }
                        if (ACT == 3) { v0[j] = 0.6065306597f * sigmoidf_(v0[j]); v1[j] = 0.6065306597f * sigmoidf_(v1[j]); }
                    }
                    u32x4 w;
#ifdef PKRTZ
                    if (ACT == 3) { typedef _Float16 h2_ __attribute__((ext_vector_type(2))); h2_ q0 = __builtin_amdgcn_cvt_pkrtz(v0[0], v0[1]), q1 = __builtin_amdgcn_cvt_pkrtz(v0[2], v0[3]), q2 = __builtin_amdgcn_cvt_pkrtz(v1[0], v1[1]), q3 = __builtin_amdgcn_cvt_pkrtz(v1[2], v1[3]);
                        w.x = __builtin_bit_cast(unsigned, q0); w.y = __builtin_bit_cast(unsigned, q1); w.z = __builtin_bit_cast(unsigned, q2); w.w = __builtin_bit_cast(unsigned, q3); } else
#endif
                    if (ACT == 3) {
                        w.x = f2h(v0[0]) | ((unsigned)f2h(v0[1]) << 16); w.y = f2h(v0[2]) | ((unsigned)f2h(v0[3]) << 16);
                        w.z = f2h(v1[0]) | ((unsigned)f2h(v1[1]) << 16); w.w = f2h(v1[2]) | ((unsigned)f2h(v1[3]) << 16);
                    } else { w.x = pk2(v0[0], v0[1]); w.y = pk2(v0[2], v0[3]); w.z = pk2(v1[0], v1[1]); w.w = pk2(v1[2], v1[3]); }
                    *(u32x4*)rowp = w;
                }
    }
    __device__ __forceinline__ void operator()(const f32x4 (&acc)[2][2][4][2], const pg8::Unit& u, int wr, int wc, int fr, int fq) const {
        const int row0 = u.pm * 256 + wr * 64 + fr, cl = wc * 32 + 8 * fq;
        if (mode == 1) {
            if (u.pn < 12) body<0>(acc, O0 + (size_t)(u.pn >> 2) * ((size_t)MP * D), D, row0, (u.pn & 3) * 256 + cl);
            else if (u.pn == 12) body<1>(acc, O1, 256, row0, cl);
            else if (u.pn == 13) body<0>(acc, O1 + (size_t)MP * 256, 256, row0, cl);
            else body<2>(acc, O1 + (size_t)2 * MP * 256, 256, row0, cl);
        } else if (mode == 2) body<3>(acc, O0, ldo, row0, u.pn * 256 + cl);
        else if (mode == 3) body<2>(acc, O0, ldo, row0, u.pn * 256 + cl);
        else body<0>(acc, O0, ldo, row0, u.pn * 256 + cl);
    }
};

template <class Epi>
__device__ __forceinline__ void run_gemm(unsigned char* smem, const bf16_t* A, const bf16_t* Bt, int N, int K, const Epi E, int rot, int Mrows = MP, int ld = 0) {
    pg8::Gemm g; g.A = A; g.Bt = Bt; g.M = Mrows; g.N = N; g.K = K; g.ld = ld ? ld : K;
    pg8::StaticOrder S; S.init(Mrows, N, (int)gridDim.x, (int)((blockIdx.x + rot) % gridDim.x));
    pg8::gemm_phase<Epi, pg8::StaticOrder, false>((PG8_LAS unsigned char*)smem, g, S, E, nullptr);
    __syncthreads();
}

struct EpiTailPart {
    static constexpr bool PERM = false, AFTER_DRAIN = false;
    float* PART; float scale;
    __device__ __forceinline__ void operator()(const f32x4 (&acc)[2][2][4][2], const pg8::Unit& u, int wr, int wc, int fr, int fq) const {
        const int lrow0 = wr * 64 + fr, col0 = (u.pn & 3) * 256 + wc * 32 + 4 * fq;
        float* base = PART + (size_t)(u.pn >> 2) * ((size_t)(M - MMAIN) * D);
#pragma unroll
        for (int m = 0; m < 4; ++m) {
            const int lrow = lrow0 + m * 16;
            if (lrow < M - MMAIN) {
                float* hp = base + (size_t)lrow * D + col0;
#pragma unroll
                for (int bj = 0; bj < 2; ++bj)
#pragma unroll
                    for (int n = 0; n < 2; ++n) *(f32x4*)(hp + bj * 128 + n * 16) = acc[0][bj][m][n] * scale;
            }
        }
    }
};
__device__ __forceinline__ void run_gemm_tail(unsigned char* smem, const bf16_t* A, const bf16_t* Bt, int K, float* PART, float scale, int rot, int ld = 0) {
    if (!ld) ld = K;
    pg8::Gemm g; g.A = A + (size_t)MMAIN * ld; g.Bt = Bt; g.M = 256; g.N = D; g.K = 256; g.ld = ld;
    pg8::SplitKOrder S; S.init(4, K / 256, (int)gridDim.x, (int)((blockIdx.x + rot) % gridDim.x));
    EpiTailPart E; E.PART = PART; E.scale = scale;
    pg8::gemm_phase<EpiTailPart, pg8::SplitKOrder, false>((PG8_LAS unsigned char*)smem, g, S, E, nullptr);
    __syncthreads();
}

constexpr int SC_STEP = 356, SC_TC = 32;
__device__ __forceinline__ void scan_phase(const Params& p, unsigned char* ws, bf16_t* Y, unsigned char* smem) {
    float* buf = (float*)smem;
    float* ybuf = (float*)(smem + 2 * SC_TC * SC_STEP * 4);
    const bf16_t* Rr = (const bf16_t*)(ws + OFF_RKV); const bf16_t* Kr = Rr + (size_t)MP * D; const bf16_t* Vr = Kr + (size_t)MP * D;
    const bf16_t* As = (const bf16_t*)(ws + OFF_ASIG); const bf16_t* Eh = (const bf16_t*)(ws + OFF_E);
    int tid = threadIdx.x; asm volatile("" : "+v"(tid));
    const bool is_comp = tid < 256;
    const int sub = tid & 15, grp = (tid >> 4) & 15;
    constexpr int NCH = (T + SC_TC - 1) / SC_TC;
    typedef float f32x2_ __attribute__((ext_vector_type(2)));
    for (int item = blockIdx.x; item < 256; item += gridDim.x) {
        const int b = item >> 5, h = (item >> 1) & 15, half = item & 1;
        const int cb = h * 64 + 4 * sub;
        f32x4 kkc, kac, w0c, a0c;
        if (!is_comp) { kkc = *(const f32x4*)(p.in[18] + cb); kac = *(const f32x4*)(p.in[19] + cb); w0c = *(const f32x4*)(p.in[10] + cb); a0c = *(const f32x4*)(p.in[13] + cb); }
        auto stage2 = [&](int c, float* dstb) {
            u32x2 pr[2], pk[2], pa[2], pe[2], pv[2];
#pragma unroll
            for (int q = 0; q < 2; ++q) {
                const int t = c * SC_TC + grp + 16 * q;
                pr[q] = (u32x2){0u, 0u}; pk[q] = pr[q]; pa[q] = pr[q]; pe[q] = pr[q]; pv[q] = pr[q];
                if (t < T) {
                    const size_t ro = ((size_t)b * T + t) * D;
                    pr[q] = *(const u32x2*)(Rr + ro + cb); pk[q] = *(const u32x2*)(Kr + ro + cb); pa[q] = *(const u32x2*)(As + ro + cb); pe[q] = *(const u32x2*)(Eh + ro + cb);
                    if (sub < 8) pv[q] = *(const u32x2*)(Vr + ro + h * 64 + half * 32 + 4 * sub);
                }
            }
#pragma unroll
            for (int q = 0; q < 2; ++q) {
                float* sp = dstb + (grp + 16 * q) * SC_STEP;
                const f32x4 r4 = (f32x4){bf_lo(pr[q].x), bf_hi(pr[q].x), bf_lo(pr[q].y), bf_hi(pr[q].y)};
                const f32x4 k4 = (f32x4){bf_lo(pk[q].x), bf_hi(pk[q].x), bf_lo(pk[q].y), bf_hi(pk[q].y)};
                f32x4 a4 = (f32x4){bf_lo(pa[q].x), bf_hi(pa[q].x), bf_lo(pa[q].y), bf_hi(pa[q].y)} + a0c;
                a4.x = sigmoidf_(a4.x); a4.y = sigmoidf_(a4.y); a4.z = sigmoidf_(a4.z); a4.w = sigmoidf_(a4.w);
                f32x4 e4 = (f32x4){bf_lo(pe[q].x), bf_hi(pe[q].x), bf_lo(pe[q].y), bf_hi(pe[q].y)} + w0c;
                e4.x = 0.6065306597f * sigmoidf_(e4.x); e4.y = 0.6065306597f * sigmoidf_(e4.y); e4.z = 0.6065306597f * sigmoidf_(e4.z); e4.w = 0.6065306597f * sigmoidf_(e4.w);
                f32x4 kk = k4 * kkc;
                const float ss = row16_sum(kk.x * kk.x + kk.y * kk.y + kk.z * kk.z + kk.w * kk.w);
                const float inv = 1.0f / fmaxf(sqrtf(ss), 1e-12f);
                kk = kk * inv;
                const f32x4 kf = k4 * (1.0f + (a4 - 1.0f) * kac);
                f32x4 w; w.x = __expf(-e4.x); w.y = __expf(-e4.y); w.z = __expf(-e4.z); w.w = __expf(-e4.w);
                const f32x4 Bv = kk * a4, WR = w * r4;
                const float br = row16_sum(Bv.x * r4.x + Bv.y * r4.y + Bv.z * r4.z + Bv.w * r4.w);
                const float kr = row16_sum(kf.x * r4.x + kf.y * r4.y + kf.z * r4.z + kf.w * r4.w);
                *(f32x4*)(sp + 4 * sub) = -kk; *(f32x4*)(sp + 64 + 4 * sub) = WR; *(f32x4*)(sp + 128 + 4 * sub) = w; *(f32x4*)(sp + 192 + 4 * sub) = Bv; *(f32x4*)(sp + 256 + 4 * sub) = kf;
                if (sub < 8) *(f32x4*)(sp + 320 + 4 * sub) = (f32x4){bf_lo(pv[q].x), bf_hi(pv[q].x), bf_lo(pv[q].y), bf_hi(pv[q].y)};
                if (sub == 0) { sp[352] = br; sp[353] = kr; }
            }
        };
        auto yout = [&](int c) {
            const int st = (tid - 256) >> 3, r4i = (tid & 7) * 4, t = c * SC_TC + st;
            if (t < T) {
                const f32x4 yv = *(const f32x4*)(ybuf + (c & 1) * (SC_TC * 32) + st * 32 + r4i);
                *(u32x2*)(Y + ((size_t)b * T + t) * D + h * 64 + half * 32 + r4i) = (u32x2){pk2(yv.x, yv.y), pk2(yv.z, yv.w)};
            }
        };
        if (!is_comp) stage2(0, buf);
        __syncthreads();
        f32x2_ Sa01 = (f32x2_){0.f, 0.f}, Sa23 = Sa01, Sb01 = Sa01, Sb23 = Sa01;
        for (int c = 0; c < NCH; ++c) {
            if (is_comp) {
                const int nst = (T - c * SC_TC) < SC_TC ? (T - c * SC_TC) : SC_TC;
                const float* cbuf = buf + (c & 1) * (SC_TC * SC_STEP); float* yb = ybuf + (c & 1) * (SC_TC * 32);
#define SC_LDO(X, s_) do { const float* sp_ = cbuf + (s_) * SC_STEP; \
                    A4##X = *(const f32x4*)(sp_ + 4 * sub); WR4##X = *(const f32x4*)(sp_ + 64 + 4 * sub); W4##X = *(const f32x4*)(sp_ + 128 + 4 * sub); \
                    B4##X = *(const f32x4*)(sp_ + 192 + 4 * sub); K4##X = *(const f32x4*)(sp_ + 256 + 4 * sub); \
                    via##X = sp_[320 + grp]; vib##X = sp_[336 + grp]; bk##X = *(const f32x2_*)(sp_ + 352); } while (0)
#define SC_STEPF(X, s_) do { \
                    const f32x2_ A01 = (f32x2_){A4##X.x, A4##X.y}, A23 = (f32x2_){A4##X.z, A4##X.w}, R01 = (f32x2_){WR4##X.x, WR4##X.y}, R23 = (f32x2_){WR4##X.z, WR4##X.w}; \
                    const f32x2_ sa2 = Sa01 * A01 + Sa23 * A23, sb2 = Sb01 * A01 + Sb23 * A23; \
                    const f32x2_ ya2 = Sa01 * R01 + Sa23 * R23, yb2 = Sb01 * R01 + Sb23 * R23; \
                    const float sa = row16_sum(sa2.x + sa2.y), sb = row16_sum(sb2.x + sb2.y), ypa = row16_sum(ya2.x + ya2.y), ypb = row16_sum(yb2.x + yb2.y); \
                    const f32x2_ W01 = (f32x2_){W4##X.x, W4##X.y}, W23 = (f32x2_){W4##X.z, W4##X.w}, B01 = (f32x2_){B4##X.x, B4##X.y}, B23 = (f32x2_){B4##X.z, B4##X.w}, K01 = (f32x2_){K4##X.x, K4##X.y}, K23 = (f32x2_){K4##X.z, K4##X.w}; \
                    const f32x2_ sav = (f32x2_){sa, sa}, sbv = (f32x2_){sb, sb}, vav = (f32x2_){via##X, via##X}, vbv = (f32x2_){vib##X, vib##X}; \
                    Sa01 = Sa01 * W01 + (sav * B01 + vav * K01); Sa23 = Sa23 * W23 + (sav * B23 + vav * K23); \
                    Sb01 = Sb01 * W01 + (sbv * B01 + vbv * K01); Sb23 = Sb23 * W23 + (sbv * B23 + vbv * K23); \
                    if (sub == 0) { yb[(s_) * 32 + grp] = ypa + sa * bk##X.x + via##X * bk##X.y; yb[(s_) * 32 + 16 + grp] = ypb + sb * bk##X.x + vib##X * bk##X.y; } } while (0)
                f32x4 A4a, WR4a, W4a, B4a, K4a, A4b, WR4b, W4b, B4b, K4b; float viaa, viba, viab, vibb; f32x2_ bka, bkb;
                SC_LDO(a, 0);
                for (int s = 0; s < nst; s += 2) {
                    SC_LDO(b, s + 1);
                    SC_STEPF(a, s);
                    if (s + 2 < nst) SC_LDO(a, s + 2);
                    SC_STEPF(b, s + 1);
                }
            } else {
                if (c > 0) yout(c - 1);
                if (c + 1 < NCH) stage2(c + 1, buf + ((c + 1) & 1) * (SC_TC * SC_STEP));
            }
            __syncthreads();
        }
        if (!is_comp) yout(NCH - 1);
        __syncthreads();
    }
}

__device__ __forceinline__ void rwkv_post_phase(const Params& p, unsigned char* ws, bf16_t* Y, int gw, int ngw, int lane) {
    const bf16_t* Rr = (const bf16_t*)(ws + OFF_RKV); const bf16_t* Kr = Rr + (size_t)MP * D; const bf16_t* Vr = Kr + (size_t)MP * D;
    const bf16_t* As = (const bf16_t*)(ws + OFF_ASIG); const bf16_t* G = (const bf16_t*)(ws + OFF_E);
    const int grp = lane >> 4, sub = lane & 15;
    constexpr int NI = 4;
    for (int w0 = gw; w0 < MP * 4; w0 += NI * ngw) {
        u32x2 uy[NI], ur[NI], uk[NI], uv[NI], ua[NI], ug[NI]; size_t os[NI]; int c0s[NI], st[NI];
#pragma unroll
        for (int i = 0; i < NI; ++i) {
            const int w = w0 + i * ngw, wc = (w < MP * 4) ? w : w0;
            const int row = wc >> 2, q = wc & 3; c0s[i] = (q * 4 + grp) * 64 + 4 * sub; os[i] = (size_t)row * D + c0s[i];
            st[i] = (w >= MP * 4) ? 2 : ((row >= M) ? 1 : 0);
            const size_t o = (row >= M) ? (size_t)c0s[i] : os[i];
            uy[i] = *(const u32x2*)(Y + o); ur[i] = *(const u32x2*)(Rr + o); uk[i] = *(const u32x2*)(Kr + o); uv[i] = *(const u32x2*)(Vr + o); ua[i] = *(const u32x2*)(As + o); ug[i] = *(const u32x2*)(G + o);
        }
#pragma unroll
        for (int i = 0; i < NI; ++i) {
            const int c0 = c0s[i];
            const f32x4 y = (f32x4){bf_lo(uy[i].x), bf_hi(uy[i].x), bf_lo(uy[i].y), bf_hi(uy[i].y)}, r = (f32x4){bf_lo(ur[i].x), bf_hi(ur[i].x), bf_lo(ur[i].y), bf_hi(ur[i].y)};
            const f32x4 k = (f32x4){bf_lo(uk[i].x), bf_hi(uk[i].x), bf_lo(uk[i].y), bf_hi(uk[i].y)}, v = (f32x4){bf_lo(uv[i].x), bf_hi(uv[i].x), bf_lo(uv[i].y), bf_hi(uv[i].y)};
            f32x4 a = (f32x4){bf_lo(ua[i].x), bf_hi(ua[i].x), bf_lo(ua[i].y), bf_hi(ua[i].y)} + *(const f32x4*)(p.in[13] + c0);
            a.x = sigmoidf_(a.x); a.y = sigmoidf_(a.y); a.z = sigmoidf_(a.z); a.w = sigmoidf_(a.w);
            const f32x4 g = (f32x4){bf_lo(ug[i].x), bf_hi(ug[i].x), bf_lo(ug[i].y), bf_hi(ug[i].y)};
            const f32x4 kac = *(const f32x4*)(p.in[19] + c0), rkc = *(const f32x4*)(p.in[20] + c0), lg = *(const f32x4*)(p.in[21] + c0), lb = *(const f32x4*)(p.in[22] + c0);
            const f32x4 kf = k * (1.0f + (a - 1.0f) * kac);
            const f32x4 t3 = r * kf * rkc;
            const float rk = row16_sum(t3.x + t3.y + t3.z + t3.w);
            const float mu = row16_sum(y.x + y.y + y.z + y.w) * (1.0f / 64.0f);
            const f32x4 dlt = y - mu;
            const float var = row16_sum(dlt.x * dlt.x + dlt.y * dlt.y + dlt.z * dlt.z + dlt.w * dlt.w) * (1.0f / 64.0f);
            const float rs = 1.0f / sqrtf(var + 64e-5f);
            const f32x4 z = ((dlt * rs) * lg + lb + v * rk) * g;
            if (st[i] == 0) *(u32x2*)(Y + os[i]) = (u32x2){pk2(z.x, z.y), pk2(z.z, z.w)};
            else if (st[i] == 1) *(u32x2*)(Y + os[i]) = (u32x2){0u, 0u};
        }
    }
}

__device__ __forceinline__ void rope_table_phase(const Params& p, float* TAB, int gtid, int ngt) {
    for (int i = gtid; i < T * 8; i += ngt) {
        const int t = i >> 3, k = i & 7;
        const float ang = (float)t * p.inv[k];
        double rev = (double)ang * 0.15915494309189535; rev -= rint(rev);
        const float rf = (float)rev;
        TAB[t * 16 + k] = __builtin_amdgcn_cosf(rf); TAB[t * 16 + 8 + k] = __builtin_amdgcn_sinf(rf);
    }
}
__device__ __forceinline__ void attn_post_phase(const Params& p, bf16_t* P, const float* TAB, int gw, int ngw, int lane) {
    const int grp = lane >> 4, sub = lane & 15;
    const f32x4 qg = *(const f32x4*)(p.in[24] + 4 * sub), kg = *(const f32x4*)(p.in[25] + 4 * sub);
    constexpr int NI = 8;
    for (int w0 = gw; w0 < M * 8; w0 += NI * ngw) {
        u32x2 raw[NI]; bf16_t* ptrs[NI]; int us[NI], ts[NI];
#pragma unroll
        for (int i = 0; i < NI; ++i) {
            const int w = w0 + i * ngw, wc = (w < M * 8) ? w : w0;
            const int row = wc >> 3; int q4 = wc & 7; if (q4 >= 5) q4 += 1;
            us[i] = (w < M * 8) ? (4 * q4 + grp) : 99; ts[i] = row % T;
            ptrs[i] = P + (size_t)row * PW + 64 * (4 * q4 + grp) + 4 * sub;
            raw[i] = *(const u32x2*)ptrs[i];
        }
#pragma unroll
        for (int i = 0; i < NI; ++i) {
            const int u = us[i], t = ts[i];
            f32x4 x = (f32x4){bf_lo(raw[i].x), bf_hi(raw[i].x), bf_lo(raw[i].y), bf_hi(raw[i].y)};
            const bool isq = u < 16, isk = (u >= 16) && (u < 20), dorope = (u < 20) || (u >= 24 && u <= 32);
            const float ss = row16_sum(x.x * x.x + x.y * x.y + x.z * x.z + x.w * x.w) * (1.0f / 64.0f);
            if (isq || isk) { const float rs = 1.0f / sqrtf(ss + 1e-6f); x = x * rs * (isq ? qg : kg); }
            f32x4 xp; xp.x = dppmov<0x4E>(x.x); xp.y = dppmov<0x4E>(x.y); xp.z = dppmov<0x4E>(x.z); xp.w = dppmov<0x4E>(x.w);
            if (dorope && sub < 4) {
                const float* tb = TAB + t * 16 + (sub & 1) * 4;
                const f32x4 c = *(const f32x4*)tb, s = *(const f32x4*)(tb + 8);
                x = (sub < 2) ? (x * c - xp * s) : (x * c + xp * s);
            }
            if (u == 33) { if (sub < 2) x = x * 0.04419417382f; }
            if (u < 34) *(u32x2*)ptrs[i] = (u32x2){pk2(x.x, x.y), pk2(x.z, x.w)};
        }
    }
}

constexpr int AT_WAVE_LDS = 16448 + 512;
__device__ __forceinline__ void attn_main_phase(const bf16_t* P, bf16_t* AO, unsigned char* smem, int wave, int lane_in, int bid, int nblk) {
    float* sc = (float*)(smem + wave * AT_WAVE_LDS);
    unsigned short* idxl = (unsigned short*)(smem + wave * AT_WAVE_LDS + 16448);
    const int b = bid & 7;
    const float NEG_INF = -__builtin_huge_valf();
    const bf16_t* pb = P + (size_t)b * T * PW;
    for (int ug = (bid >> 3); ug < T / 8; ug += (nblk >> 3)) {
        int lane = lane_in; asm volatile("" : "+v"(lane));
        const int n15 = lane & 15, kq = lane >> 4;
        const int t0 = ug * 8, t = t0 + wave;
        const size_t row = (size_t)b * T + t;
        const bf16_t* prow = P + row * PW;
        int nsel;
        if (t0 >= 256) {
            nsel = 256;
            bf16x8 ia[4][2]; float w4[4][4];
#pragma unroll
            for (int mt = 0; mt < 4; ++mt) {
                const bf16_t* qp = pb + (size_t)(t0 + 2 * mt + (n15 >> 3)) * PW + 1536 + (n15 & 7) * 64 + kq * 8;
                ia[mt][0] = *(const bf16x8*)qp; ia[mt][1] = *(const bf16x8*)(qp + 32);
                const u32x2 wr = *(const u32x2*)(pb + (size_t)(t0 + 2 * mt + (kq >> 1)) * PW + 2112 + 4 * (kq & 1));
                w4[mt][0] = bf_lo(wr.x); w4[mt][1] = bf_hi(wr.x); w4[mt][2] = bf_lo(wr.y); w4[mt][3] = bf_hi(wr.y);
            }
            const int ntb = ((t0 + 7) >> 4) + 1;
            auto ldk = [&](bf16x8& d0, bf16x8& d1, int kt) { const bf16_t* kb = pb + (size_t)(16 * kt + n15) * PW + 2048 + kq * 8; d0 = *(const bf16x8*)kb; d1 = *(const bf16x8*)(kb + 32); };
            auto cmp = [&](const bf16x8& d0, const bf16x8& d1, int kt) {
#pragma unroll
                for (int mt = 0; mt < 4; ++mt) {
                    f32x4 acc = (f32x4){0.f, 0.f, 0.f, 0.f};
                    acc = __builtin_amdgcn_mfma_f32_16x16x32_bf16(ia[mt][0], d0, acc, 0, 0, 0);
                    acc = __builtin_amdgcn_mfma_f32_16x16x32_bf16(ia[mt][1], d1, acc, 0, 0, 0);
                    float ps = w4[mt][0] * fmaxf(acc[0], 0.f) + w4[mt][1] * fmaxf(acc[1], 0.f) + w4[mt][2] * fmaxf(acc[2], 0.f) + w4[mt][3] * fmaxf(acc[3], 0.f);
                    ps += __shfl_xor(ps, 16);
                    if ((kq & 1) == 0) ((float*)(smem + (2 * mt + (kq >> 1)) * AT_WAVE_LDS))[16 * kt + n15] = ps;
                }
            };
            bf16x8 xa0, xa1, xb0, xb1, xc0, xc1, xd0, xd1;
            int kt = wave;
            if (kt < ntb) ldk(xa0, xa1, kt);
            if (kt + 8 < ntb) ldk(xb0, xb1, kt + 8);
            if (kt + 16 < ntb) ldk(xc0, xc1, kt + 16);
            for (; kt < ntb; kt += 32) {
                if (kt + 24 < ntb) ldk(xd0, xd1, kt + 24);
                cmp(xa0, xa1, kt);
                if (kt + 32 < ntb) ldk(xa0, xa1, kt + 32);
                if (kt + 8 < ntb) cmp(xb0, xb1, kt + 8);
                if (kt + 40 < ntb) ldk(xb0, xb1, kt + 40);
                if (kt + 16 < ntb) cmp(xc0, xc1, kt + 16);
                if (kt + 48 < ntb) ldk(xc0, xc1, kt + 48);
                if (kt + 24 < ntb) cmp(xd0, xd1, kt + 24);
            }
            __syncthreads();
            unsigned key[65];
#pragma unroll
            for (int r = 0; r < 65; ++r) {
                const int e = r * 64 + lane;
                unsigned uu = __float_as_uint(sc[e]);
                if (uu == 0x80000000u) uu = 0u;
                uu = (uu & 0x80000000u) ? ~uu : (uu | 0x80000000u);
                key[r] = (e <= t) ? uu : 0u;
            }
            unsigned Tk = 0u;
            for (int bit = 31; bit >= 16; --bit) {
                const unsigned cand = Tk | (1u << bit);
                int cnt = 0;
#pragma unroll
                for (int gi = 0; gi < 5; ++gi) {
                    if (gi * 832 <= t) {
#pragma unroll
                        for (int rr = 0; rr < 13; ++rr) cnt += __popcll(__ballot(key[gi * 13 + rr] >= cand));
                    }
                }
                if (cnt >= 256) Tk = cand;
            }
            {
                const unsigned up = Tk + 0x10000u, hsel = Tk >> 16;
                int c_hi = 0, nc = 0;
                unsigned* cl = (unsigned*)sc;
                lds_wave_sync();
#pragma unroll
                for (int r = 0; r < 65; ++r) {
                    const bool hi = (up != 0u) && (key[r] >= up), cd = (key[r] >> 16) == hsel;
                    c_hi += __popcll(__ballot(hi));
                    const unsigned long long mc = __ballot(cd);
                    const int pos = nc + (int)__builtin_amdgcn_mbcnt_hi((unsigned)(mc >> 32), __builtin_amdgcn_mbcnt_lo((unsigned)mc, 0u));
                    if (cd) cl[pos] = key[r] & 0xffffu;
                    nc += __popcll(mc);
                }
                lds_wave_sync();
                const int nch = (nc + 63) >> 6;
                unsigned L = 0u;
                for (int bit = 15; bit >= 0; --bit) {
                    const unsigned cand = L | (1u << bit);
                    int cnt = c_hi;
                    for (int i = 0; i < nch; ++i) { const int ix = i * 64 + lane; const unsigned v = cl[ix]; cnt += __popcll(__ballot((ix < nc) && (v >= cand))); }
                    if (cnt >= 256) L = cand;
                }
                Tk |= L;
            }
            int ngt = 0;
#pragma unroll
            for (int r = 0; r < 65; ++r) ngt += __popcll(__ballot(key[r] > Tk));
            const int need = 256 - ngt;
            lds_wave_sync();
            int pg = 0, pe = 0;
#pragma unroll
            for (int r = 0; r < 65; ++r) {
                const int e = r * 64 + lane;
                const bool gt = key[r] > Tk, eq = key[r] == Tk;
                const unsigned long long mg = __ballot(gt), me = __ballot(eq);
                const int og = pg + (int)__builtin_amdgcn_mbcnt_hi((unsigned)(mg >> 32), __builtin_amdgcn_mbcnt_lo((unsigned)mg, 0u));
                const int oe = pe + (int)__builtin_amdgcn_mbcnt_hi((unsigned)(me >> 32), __builtin_amdgcn_mbcnt_lo((unsigned)me, 0u));
                if (gt) idxl[og] = (unsigned short)e;
                if (eq && oe < need) idxl[ngt + oe] = (unsigned short)e;
                pg += __popcll(mg); pe += __popcll(me);
            }
        } else {
            nsel = t + 1;
#pragma unroll
            for (int j = 0; j < 4; ++j) { const int e = j * 64 + lane; idxl[e] = (unsigned short)(e < t ? e : t); }
        }
        lds_wave_sync();
        const int ntile = (nsel + 15) >> 4;
        const bf16x8 qa0 = *(const bf16x8*)(prow + n15 * 64 + kq * 8), qa1 = *(const bf16x8*)(prow + n15 * 64 + 32 + kq * 8);
        f32x4 mx4 = (f32x4){NEG_INF, NEG_INF, NEG_INF, NEG_INF};
        {
            auto ldt = [&](bf16x8 (&d)[8], int kt) {
                const int krow = idxl[16 * kt + n15];
                const bf16_t* kb = pb + (size_t)krow * PW + 1024 + kq * 8;
#pragma unroll
                for (int i = 0; i < 8; ++i) d[i] = *(const bf16x8*)(kb + 32 * i);
            };
            auto cmt = [&](const bf16x8 (&d)[8], int kt) {
                const int j = 16 * kt + n15;
                f32x4 a0 = (f32x4){0.f, 0.f, 0.f, 0.f}, a1 = a0, a2 = a0, a3 = a0;
                a0 = __builtin_amdgcn_mfma_f32_16x16x32_bf16(qa0, d[0], a0, 0, 0, 0); a0 = __builtin_amdgcn_mfma_f32_16x16x32_bf16(qa1, d[1], a0, 0, 0, 0);
                a1 = __builtin_amdgcn_mfma_f32_16x16x32_bf16(qa0, d[2], a1, 0, 0, 0); a1 = __builtin_amdgcn_mfma_f32_16x16x32_bf16(qa1, d[3], a1, 0, 0, 0);
                a2 = __builtin_amdgcn_mfma_f32_16x16x32_bf16(qa0, d[4], a2, 0, 0, 0); a2 = __builtin_amdgcn_mfma_f32_16x16x32_bf16(qa1, d[5], a2, 0, 0, 0);
                a3 = __builtin_amdgcn_mfma_f32_16x16x32_bf16(qa0, d[6], a3, 0, 0, 0); a3 = __builtin_amdgcn_mfma_f32_16x16x32_bf16(qa1, d[7], a3, 0, 0, 0);
                f32x4 sel = (kq == 0) ? a0 : ((kq == 1) ? a1 : ((kq == 2) ? a2 : a3));
#pragma unroll
                for (int r = 0; r < 4; ++r) { sel[r] = (j < nsel) ? sel[r] * 0.125f : NEG_INF; mx4[r] = fmaxf(mx4[r], sel[r]); }
                *(f32x4*)(sc + j * 16 + 4 * kq) = sel;
            };
            bf16x8 ka[8], kb2[8];
            ldt(ka, 0);
            for (int kt = 0; kt < ntile; kt += 2) {
                if (kt + 1 < ntile) ldt(kb2, kt + 1);
                cmt(ka, kt);
                if (kt + 2 < ntile) ldt(ka, kt + 2);
                if (kt + 1 < ntile) cmt(kb2, kt + 1);
            }
        }
#pragma unroll
        for (int r = 0; r < 4; ++r) mx4[r] = row16_max(mx4[r]);
        f32x4 sm4 = (f32x4){0.f, 0.f, 0.f, 0.f};
        for (int kt = 0; kt < ntile; ++kt) {
            float* pp = sc + (16 * kt + n15) * 16 + 4 * kq;
            f32x4 v = *(const f32x4*)pp;
#pragma unroll
            for (int r = 0; r < 4; ++r) { v[r] = __expf(v[r] - mx4[r]); sm4[r] += v[r]; }
            *(f32x4*)pp = v;
        }
#pragma unroll
        for (int r = 0; r < 4; ++r) sm4[r] = 1.0f / row16_sum(sm4[r]);
        float* invl = sc + 4096;
        if (n15 == 0) *(f32x4*)(invl + 4 * kq) = sm4;
        lds_wave_sync();
        const int kp = lane >> 5, dp = lane & 31;
        float o[4][4][2];
#pragma unroll
        for (int g = 0; g < 4; ++g)
#pragma unroll
            for (int hh = 0; hh < 4; ++hh) { o[g][hh][0] = 0.f; o[g][hh][1] = 0.f; }
        {
            auto ldv = [&](unsigned (&d)[4][4], int jp0) {
#pragma unroll
                for (int i = 0; i < 4; ++i) {
                    const int krow = idxl[2 * (jp0 + i) + kp];
                    const bf16_t* vb = pb + (size_t)krow * PW + 1280 + 2 * dp;
#pragma unroll
                    for (int g = 0; g < 4; ++g) d[i][g] = *(const unsigned*)(vb + 64 * g);
                }
            };
            auto cmv = [&](const unsigned (&d)[4][4], int jp0) {
#pragma unroll
                for (int i = 0; i < 4; ++i) {
                    const int j = 2 * (jp0 + i) + kp;
#pragma unroll
                    for (int g = 0; g < 4; ++g) {
                        const float v0 = bf_lo(d[i][g]), v1 = bf_hi(d[i][g]);
                        const f32x4 p4 = *(const f32x4*)(sc + j * 16 + 4 * g);
#pragma unroll
                        for (int hh = 0; hh < 4; ++hh) { o[g][hh][0] += p4[hh] * v0; o[g][hh][1] += p4[hh] * v1; }
                    }
                }
            };
            unsigned va[4][4], vb2[4][4];
            const int npairs = 8 * ntile;
            ldv(va, 0);
            for (int c0 = 0; c0 < npairs; c0 += 8) {
                ldv(vb2, c0 + 4);
                cmv(va, c0);
                if (c0 + 8 < npairs) ldv(va, c0 + 8);
                cmv(vb2, c0 + 4);
            }
        }
#pragma unroll
        for (int g = 0; g < 4; ++g) {
            const f32x4 iv = *(const f32x4*)(invl + 4 * g);
#pragma unroll
            for (int hh = 0; hh < 4; ++hh) {
                const float o0 = (o[g][hh][0] + __shfl_xor(o[g][hh][0], 32)) * iv[hh], o1 = (o[g][hh][1] + __shfl_xor(o[g][hh][1], 32)) * iv[hh];
                if (lane < 32) *(unsigned*)(AO + row * D + (4 * g + hh) * 64 + 2 * dp) = pk2(o0, o1);
            }
        }
        __syncthreads();
    }
}

__device__ __forceinline__ void tail_reduce(float* H, const float* PART, int ns, int gtid, int ngt) {
    for (int i = gtid; i < (M - MMAIN) * D / 4; i += ngt) {
        f32x4 v = *(const f32x4*)(H + (size_t)MMAIN * D + (size_t)i * 4);
        for (int s = 0; s < ns; ++s) v = v + *(const f32x4*)(PART + (size_t)s * ((size_t)(M - MMAIN) * D) + (size_t)i * 4);
        *(f32x4*)(H + (size_t)MMAIN * D + (size_t)i * 4) = v;
    }
}

struct Ctx { int tid, lane, wave, gw, ngw, bid, nblk; };
__device__ __forceinline__ Ctx mkctx() {
    int tid = threadIdx.x, bid = blockIdx.x, nb = gridDim.x;
    asm volatile("" : "+v"(tid)); asm volatile("" : "+s"(bid)); asm volatile("" : "+s"(nb));
    Ctx c; c.tid = tid; c.lane = tid & 63; c.wave = __builtin_amdgcn_readfirstlane(tid >> 6); c.bid = bid; c.nblk = nb; c.gw = bid * 8 + c.wave; c.ngw = nb * 8; return c;
}
template <class T_> __device__ __forceinline__ T_* launder(T_* ptr) { return ptr; }

#ifdef DUP_SYNC
#define EXTRA_SYNC() grid.sync()
#else
#define EXTRA_SYNC()
#endif
#define PHASE_END() do { if (phase == 0) grid.sync(); else xcd_barrier(xb); EXTRA_SYNC(); ++phase; if (STOP_AFTER == phase) { dump_h(p, H); return; } } while (0)
__device__ __forceinline__ void dump_h(const Params& p, const float* H) {
    for (size_t i = (size_t)blockIdx.x * 512 + threadIdx.x; i < (size_t)NB * SEQ * D / 4; i += (size_t)gridDim.x * 512) {
        const size_t e = i * 4, orow = e / D, c = e % D, b_ = orow / SEQ, t_ = orow % SEQ; *(f32x4*)(p.out + e) = *(const f32x4*)(H + ((size_t)b_ * T + t_ + NMETA) * D + c); }
}

__global__ void __launch_bounds__(512, 2) fwd_mega(Params p) {
    extern __shared__ __attribute__((aligned(16))) unsigned char smem[];
    cg::grid_group grid = cg::this_grid();
    int phase = 0;
    volatile LAS unsigned* xst = (volatile LAS unsigned*)(smem + LDS_BYTES - 16);
    if (threadIdx.x == 0) { xst[0] = 0u; xst[1] = 0u; }
    __syncthreads();
    XcdBarrier xb = xcd_barrier_post((unsigned*)(p.ws + OFF_BAR), xst);
#define WS_ (launder(p.ws))
#define H_ ((float*)(WS_ + OFF_H))
#define WB_ (WS_ + OFF_WB)
    float* H = (float*)(p.ws + OFF_H);

#define FFN_BLOCK(LAYER, SUB, FI, NSPREV) do { \
        const float* ng = p.in[2] + (size_t)(LAYER) * 3 * D + (SUB) * D; \
        for (int rep_ = 0; rep_ < NREP_NORM; ++rep_) { Ctx c = mkctx(); float* scr = (float*)(smem + c.wave * 8448); int trot = 0; \
          const float* w_in = p.in[3] + ((size_t)(LAYER) * 2 + (FI)) * (size_t)D * 2 * FF; \
          const float* w_out = p.in[4] + ((size_t)(LAYER) * 2 + (FI)) * (size_t)FF * D; \
          tr_job(w_in, D, 2 * FF, 2 * FF, nullptr, 1, (bf16_t*)(WB_ + WB_W1T), D, 0, 0, 2 * FF, D, scr, c.gw, c.ngw, c.lane, trot); \
          tr_job(w_out, FF, D, D, nullptr, 0, (bf16_t*)(WB_ + WB_W2T), LDF, 0, 0, D, FF, scr, c.gw, c.ngw, c.lane, trot); \
          if ((LAYER) == 0 && (SUB) == 0) norm_phase<1>(p, ng, H_, (bf16_t*)(WS_ + OFF_XN), c.gw, c.ngw, c.lane); \
          else norm_phase<0>(p, ng, H_, (bf16_t*)(WS_ + OFF_XN), c.gw, c.ngw, c.lane, (const float*)(WS_ + OFF_PART), NSPREV); } \
        PHASE_END(); \
        { EpiSwiGLU E; E.O = (bf16_t*)(WS_ + OFF_ACT); run_gemm(smem, (const bf16_t*)(WS_ + OFF_XN), (const bf16_t*)(WB_ + WB_W1T), 2 * FF, D, E, 0); } \
        PHASE_END(); \
        { EpiResid<((LAYER) == 1 && (SUB) == 2)> E; E.H = H_; E.scale = 0.5f; E.out = p.out; run_gemm(smem, (const bf16_t*)(WS_ + OFF_ACT), (const bf16_t*)(WB_ + WB_W2T), D, FF, E, 0, MMAIN, LDF); } \
        run_gemm_tail(smem, (const bf16_t*)(WS_ + OFF_ACT), (const bf16_t*)(WB_ + WB_W2T), FF, (float*)(WS_ + OFF_PART), 0.5f, 100, LDF); \
        PHASE_END(); } while (0)

    FFN_BLOCK(0, 0, 0, 0);
#ifndef NO_RWKV
    {
        bf16_t* Y = (bf16_t*)p.out; bf16_t* L1 = (bf16_t*)((unsigned char*)p.out + SZ_B16);
        { Ctx c = mkctx(); tail_reduce(H_, (const float*)(WS_ + OFF_PART), 11, c.bid * 512 + c.tid, c.nblk * 512); }
        xcd_barrier(xb);
        for (int rep_ = 0; rep_ < NREP_NORM; ++rep_) {
            Ctx c = mkctx(); float* scr = (float*)(smem + c.wave * 8448); int trot = 0;
            bf16_t* WPT = (bf16_t*)(WB_ + WB_WPT); bf16_t* L2W = (bf16_t*)(WB_ + WB_L2W); bf16_t* WOT = (bf16_t*)(WB_ + WB_RWO);
            const float* mix = p.in[5];
            tr_job(p.in[6], D, D, D, nullptr, 0, WPT, 2 * D, 0, 0, D, D, scr, c.gw, c.ngw, c.lane, trot);
            tr_job(p.in[6], D, D, D, mix + 0 * D, 0, WPT, 2 * D, 0, D, D, D, scr, c.gw, c.ngw, c.lane, trot);
            tr_job(p.in[7], D, D, D, nullptr, 0, WPT, 2 * D, 1024, 0, D, D, scr, c.gw, c.ngw, c.lane, trot);
            tr_job(p.in[7], D, D, D, mix + 2 * D, 0, WPT, 2 * D, 1024, D, D, D, scr, c.gw, c.ngw, c.lane, trot);
            tr_job(p.in[8], D, D, D, nullptr, 0, WPT, 2 * D, 2048, 0, D, D, scr, c.gw, c.ngw, c.lane, trot);
            tr_job(p.in[8], D, D, D, mix + 3 * D, 0, WPT, 2 * D, 2048, D, D, D, scr, c.gw, c.ngw, c.lane, trot);
            tr_job(p.in[11], D, 64, 64, nullptr, 0, WPT, 2 * D, 3072, 0, 256, D, scr, c.gw, c.ngw, c.lane, trot);
            tr_job(p.in[11], D, 64, 64, mix + 1 * D, 0, WPT, 2 * D, 3072, D, 256, D, scr, c.gw, c.ngw, c.lane, trot);
            tr_job(p.in[14], D, 64, 64, nullptr, 0, WPT, 2 * D, 3328, 0, 256, D, scr, c.gw, c.ngw, c.lane, trot);
            tr_job(p.in[14], D, 64, 64, mix + 4 * D, 0, WPT, 2 * D, 3328, D, 256, D, scr, c.gw, c.ngw, c.lane, trot);
            tr_job(p.in[16], D, 160, 160, nullptr, 0, WPT, 2 * D, 3584, 0, 256, D, scr, c.gw, c.ngw, c.lane, trot);
            tr_job(p.in[16], D, 160, 160, mix + 5 * D, 0, WPT, 2 * D, 3584, D, 256, D, scr, c.gw, c.ngw, c.lane, trot);
            tr_job(p.in[12], 64, D, D, nullptr, 0, L2W, 256, 0, 0, D, 256, scr, c.gw, c.ngw, c.lane, trot);
            tr_job(p.in[15], 64, D, D, nullptr, 0, L2W + (size_t)1024 * 256, 256, 0, 0, D, 256, scr, c.gw, c.ngw, c.lane, trot);
            tr_job(p.in[17], 160, D, D, nullptr, 0, L2W + (size_t)2 * 1024 * 256, 256, 0, 0, D, 256, scr, c.gw, c.ngw, c.lane, trot);
            tr_job(p.in[9], D, D, D, nullptr, 0, WOT, D, 0, 0, D, D, scr, c.gw, c.ngw, c.lane, trot);
            norm_phase<2>(p, p.in[2] + D, H_, (bf16_t*)(WS_ + OFF_AP), c.gw, c.ngw, c.lane);
        }
        PHASE_END();
#ifndef NO_G1
        { EpiBf<1> E; E.O0 = (bf16_t*)(WS_ + OFF_RKV); E.O1 = L1; E.bias = nullptr; E.ldo = D; run_gemm(smem, (const bf16_t*)(WS_ + OFF_AP), (const bf16_t*)(WB_ + WB_WPT), 3840, 2 * D, E, 0); }
#endif
        PHASE_END();
#ifndef NO_G23
        { EpiBf<0> E; E.O0 = (bf16_t*)(WS_ + OFF_E); E.O1 = nullptr; E.bias = nullptr; E.ldo = D; run_gemm(smem, L1, (const bf16_t*)(WB_ + WB_L2W), D, 256, E, 0); }
        { EpiBf<0> E; E.O0 = (bf16_t*)(WS_ + OFF_ASIG); E.O1 = nullptr; E.bias = nullptr; E.ldo = D; run_gemm(smem, L1 + (size_t)MP * 256, (const bf16_t*)(WB_ + WB_L2W) + (size_t)1024 * 256, D, 256, E, 64); }
#endif
        PHASE_END();
#ifndef NO_SCAN
        scan_phase(p, WS_, Y, smem);
#ifdef DUP_SCAN
        grid.sync(); scan_phase(p, WS_, Y, smem);
#endif
#endif
        PHASE_END();
        { EpiBf<0> E; E.O0 = (bf16_t*)(WS_ + OFF_E); E.O1 = nullptr; E.bias = nullptr; E.ldo = D; run_gemm(smem, L1 + (size_t)2 * MP * 256, (const bf16_t*)(WB_ + WB_L2W) + (size_t)2 * 1024 * 256, D, 256, E, 128); }
        PHASE_END();
#ifndef NO_RPOST
        { Ctx c = mkctx(); rwkv_post_phase(p, WS_, Y, c.gw, c.ngw, c.lane); }
#endif
        PHASE_END();
        { EpiResid<false> E; E.H = H_; E.scale = 1.0f; E.out = nullptr; run_gemm(smem, Y, (const bf16_t*)(WB_ + WB_RWO), D, D, E, 0, MMAIN); }
        run_gemm_tail(smem, Y, (const bf16_t*)(WB_ + WB_RWO), D, (float*)(WS_ + OFF_PART), 1.0f, 100);
        PHASE_END();
    }
#endif
    FFN_BLOCK(0, 2, 1, 4);
    FFN_BLOCK(1, 0, 0, 11);
#ifndef NO_ATTN
    {
        for (int rep_ = 0; rep_ < NREP_NORM; ++rep_) {
            Ctx c = mkctx(); float* scr = (float*)(smem + c.wave * 8448); int trot = 0;
            tr_job(p.in[23], D, 2120, 2120, nullptr, 0, (bf16_t*)(WB_ + WB_WIT), D, 0, 0, PW, D, scr, c.gw, c.ngw, c.lane, trot);
            tr_job(p.in[26], D, D, D, nullptr, 0, (bf16_t*)(WB_ + WB_AWO), D, 0, 0, D, D, scr, c.gw, c.ngw, c.lane, trot);
            rope_table_phase(p, (float*)(WS_ + OFF_TAB), c.bid * 512 + c.tid, c.nblk * 512);
            norm_phase<0>(p, p.in[2] + 3 * D + D, H_, (bf16_t*)(WS_ + OFF_HN), c.gw, c.ngw, c.lane, (const float*)(WS_ + OFF_PART), 11);
        }
        PHASE_END();
        { EpiBf<0> E; E.O0 = (bf16_t*)(WS_ + OFF_P); E.O1 = nullptr; E.bias = nullptr; E.ldo = PW; run_gemm(smem, (const bf16_t*)(WS_ + OFF_HN), (const bf16_t*)(WB_ + WB_WIT), PW, D, E, 0); }
        PHASE_END();
#ifndef NO_APOST
        { Ctx c = mkctx(); attn_post_phase(p, (bf16_t*)(WS_ + OFF_P), (const float*)(WS_ + OFF_TAB), c.gw, c.ngw, c.lane); }
#endif
        PHASE_END();
#ifndef NO_AMAIN
        { Ctx c = mkctx(); attn_main_phase((const bf16_t*)(WS_ + OFF_P), (bf16_t*)(WS_ + OFF_HN), smem, c.wave, c.lane, c.bid, c.nblk); }
#ifdef DUP_AMAIN
        grid.sync(); { Ctx c = mkctx(); attn_main_phase((const bf16_t*)(WS_ + OFF_P), (bf16_t*)(WS_ + OFF_HN), smem, c.wave, c.lane, c.bid, c.nblk); }
#endif
#endif
        PHASE_END();
        { EpiResid<false> E; E.H = H_; E.scale = 1.0f; E.out = nullptr; run_gemm(smem, (const bf16_t*)(WS_ + OFF_HN), (const bf16_t*)(WB_ + WB_AWO), D, D, E, 0, MMAIN); }
        run_gemm_tail(smem, (const bf16_t*)(WS_ + OFF_HN), (const bf16_t*)(WB_ + WB_AWO), D, (float*)(WS_ + OFF_PART), 1.0f, 100);
        PHASE_END();
    }
#endif
    FFN_BLOCK(1, 2, 1, 4);
    for (int i = blockIdx.x * 512 + threadIdx.x; i < (M - MMAIN) * D / 4; i += gridDim.x * 512) {
        const int row = MMAIN + (i * 4) / D, c = (i * 4) % D, b_ = row / T, t_ = row - b_ * T;
        f32x4 v = *(const f32x4*)(H + (size_t)row * D + c);
        const float* PART = (const float*)(p.ws + OFF_PART);
        for (int s = 0; s < 11; ++s) v = v + *(const f32x4*)(PART + ((size_t)s * (M - MMAIN) + (row - MMAIN)) * D + c);
        *(f32x4*)(p.out + ((size_t)b_ * SEQ + (t_ - NMETA)) * D + c) = v;
    }
}

extern "C" void kernel_launch(void* const* d_in, const int* in_sizes, int n_in, void* d_out, int out_size, void* d_ws, size_t ws_size, hipStream_t stream) {
    static int grid_blocks = 0;
    if (!grid_blocks) {
        int dev = 0, cus = 0, per_cu = 0;
        (void)hipGetDevice(&dev);
        (void)hipDeviceGetAttribute(&cus, hipDeviceAttributeMultiprocessorCount, dev);
        if (hipFuncSetAttribute((const void*)fwd_mega, hipFuncAttributeMaxDynamicSharedMemorySize, LDS_BYTES) != hipSuccess) fprintf(stderr, "hipFuncSetAttribute failed\n");
        if (hipOccupancyMaxActiveBlocksPerMultiprocessor(&per_cu, (const void*)fwd_mega, 512, LDS_BYTES) != hipSuccess || per_cu < 1) { fprintf(stderr, "occupancy query: %d\n", per_cu); per_cu = 1; }
        (void)hipGetLastError();
        grid_blocks = cus;
        if (grid_blocks % 8) grid_blocks -= grid_blocks % 8;
        if (ws_size < ((size_t)512 << 20)) fprintf(stderr, "workspace too small: %zu\n", ws_size);
    }
    Params p{};
    for (int i = 0; i < 27; ++i) p.in[i] = (const float*)d_in[i];
    p.out = (float*)d_out; p.ws = (unsigned char*)d_ws;
    for (int i = 0; i < 8; ++i) p.inv[i] = (float)pow(500000.0, -(double)i / 8.0);
    (void)hipMemsetAsync((unsigned char*)d_ws + OFF_BAR, 0, XCD_BAR_WORDS * sizeof(unsigned), stream);
    void* args[] = {&p};
    hipError_t e = hipLaunchCooperativeKernel((const void*)fwd_mega, dim3(grid_blocks), dim3(512), args, LDS_BYTES, stream);
    if (e != hipSuccess) fprintf(stderr, "cooperative launch failed: %s (grid %d)\n", hipGetErrorString(e), grid_blocks);
}
```

```cpp
#include <hip/hip_runtime.h>
#include <hip/hip_cooperative_groups.h>
#include <cstdio>
namespace cg = cooperative_groups;
namespace pg8 {
#define PG8_LAS __attribute__((address_space(3)))
typedef unsigned short bf16_t;
typedef short bf16x8 __attribute__((ext_vector_type(8)));
typedef float f32x4 __attribute__((ext_vector_type(4)));
typedef unsigned u32x4 __attribute__((ext_vector_type(4)));
constexpr int BM = 256, BK = 64, HALF = 128, HTB = HALF * BK * 2  , STAGE_BYTES = 8 * HTB, NXCD = 8, WGM = 8;

__host__ __device__ __forceinline__ int lds_byte(int r, int c) { const int st = (r >> 4) * 2 + (c >> 5), rr = r & 15, cc = c & 31, ob = rr * 64 + cc * 2; return st * 1024 + (ob ^ (((ob >> 9) & 1) << 5)); }
__host__ __device__ __forceinline__ void stage_rc(int b, int& R, int& C) { const int st = b / 1024, sb = b % 1024, swz = sb ^ (((sb >> 9) & 1) << 5); R = (st >> 1) * 16 + swz / 64; C = (st & 1) * 32 + (swz % 64) / 2; }
__host__ __device__ __forceinline__ int perm32(int rho) { const int n = rho >> 4, i = rho & 15; return 8 * (i >> 2) + 4 * n + (i & 3); }

struct Unit { int pm, pn; };
struct Gemm { const bf16_t* A; const bf16_t* Bt; int M, N, K, ld; };

struct StaticOrder {
    int nM, nN, nwg, G, c;
    __host__ __device__ void init(int M, int N, int G_, int c_) { nM = M / BM; nN = N / BM; nwg = nM * nN; G = G_; c = c_; }
    __host__ __device__ bool next(int i, Unit& u) const {
        const long L = (long)i * G + c; if (L >= nwg) return false;
        int wgid = (int)L; { const int q = nwg / NXCD, r = nwg % NXCD, xcd = wgid % NXCD, off = wgid / NXCD; wgid = (xcd < r ? xcd * (q + 1) : r * (q + 1) + (xcd - r) * q) + off; }
        const int nig = WGM * nN, gid = wgid / nig, fm = gid * WGM, gsz = (nM - fm) < WGM ? (nM - fm) : WGM;
        u.pm = fm + ((wgid % nig) % gsz); u.pn = (wgid % nig) / gsz; return true;
    }
    __device__ __forceinline__ void a_ready(const Unit&) const {}
    __device__ __forceinline__ void done(const Unit&) const {}
    __device__ __forceinline__ size_t aoff(const Unit& u, size_t tstep) const { return (size_t)u.pm * tstep; }
    __device__ __forceinline__ size_t boff(const Unit& u, size_t tstep) const { return (size_t)u.pn * tstep; }
};
struct SplitKOrder {
    int ncol, nun, G, c;
    __device__ void init(int ncol_, int nslice, int G_, int c_) { ncol = ncol_; nun = ncol_ * nslice; G = G_; c = c_; }
    __device__ bool next(int i, Unit& u) const { const long L = (long)i * G + c; if (L >= nun) return false; u.pm = 0; u.pn = (int)L; return true; }
    __device__ __forceinline__ void a_ready(const Unit&) const {}
    __device__ __forceinline__ void done(const Unit&) const {}
    __device__ __forceinline__ size_t aoff(const Unit& u, size_t) const { return (size_t)(u.pn / ncol) * 512; }
    __device__ __forceinline__ size_t boff(const Unit& u, size_t tstep) const { return (size_t)(u.pn % ncol) * tstep + (size_t)(u.pn / ncol) * 512; }
};
__device__ __forceinline__ unsigned cvt_pk_bf16(float lo, float hi) { unsigned r; asm volatile("v_cvt_pk_bf16_f32 %0, %1, %2" : "=v"(r) : "v"(lo), "v"(hi)); return r; }

template <class Epi, class Sched, bool STAMP = false>
__device__ __forceinline__ void gemm_phase(PG8_LAS unsigned char* lds, const Gemm g, const Sched& S, const Epi& E, unsigned long long* stamps) {
    int tid_l = threadIdx.x; asm volatile("" : "+v"(tid_l));
    const int tid = tid_l, wid = __builtin_amdgcn_readfirstlane(tid >> 6), lane = tid & 63, wr = wid >> 2, wc = wid & 3, fr = lane & 15, fq = lane >> 4;
    const int K = g.K, nt = K / BK;
    int ts_lo = 0, ts_hi = 0, nts = 0; const unsigned long long rt_entry = STAMP ? (unsigned long long)wall_clock64() : 0ull;
#define PG8_STAMP() do { if (STAMP && wid == 0 && nts < 64) { const unsigned long long _c = (unsigned long long)clock64(); \
        ts_lo = (lane == nts) ? (int)(unsigned)_c : ts_lo; ts_hi = (lane == nts) ? (int)(unsigned)(_c >> 32) : ts_hi; ++nts; } } while (0)
    PG8_STAMP();
    unsigned voffA[2], voffB[2];
#pragma unroll
    for (int i = 0; i < 2; ++i) { int R, C; stage_rc(tid * 16 + i * 8192, R, C); const int Rb = Epi::PERM ? ((R & ~31) + perm32(R & 31)) : R;
        voffA[i] = (unsigned)(R * g.ld + C) * 2u; voffB[i] = (unsigned)(Rb * g.ld + C) * 2u; }
    const size_t kstep = (size_t)(BK * 2);
    const size_t hstep = (size_t)HALF * g.ld * 2;
    const size_t tstep = 2 * hstep;
    const unsigned ldsw = (unsigned)wid * 1024u;
    const int aoff = lds_byte(wr * 64 + fr, fq * 8), boff = lds_byte(wc * 32 + fr, fq * 8);
#define PG8_SA(b, h) (((b) * 2 + (h)) * HTB)
#define PG8_SB(b, h) ((4 + (b) * 2 + (h)) * HTB)
#define PG8_STAGE(bufoff, gbase, voff) do { _Pragma("unroll") for (int _i = 0; _i < 2; ++_i) \
        __builtin_amdgcn_global_load_lds((const unsigned*)((const char*)(gbase) + (voff)[_i]), (PG8_LAS unsigned*)(lds + (bufoff) + ldsw + _i * 8192), 16, 0, 0); } while (0)
#define PG8_LDA(dst, b, h) do { _Pragma("unroll") for (int m = 0; m < 4; ++m) _Pragma("unroll") for (int k = 0; k < 2; ++k) dst[m][k] = *(const PG8_LAS bf16x8*)(lds + PG8_SA(b, h) + aoff + m * 2048 + k * 1024); } while (0)
#define PG8_LDB(dst, b, h) do { _Pragma("unroll") for (int n = 0; n < 2; ++n) _Pragma("unroll") for (int k = 0; k < 2; ++k) dst[n][k] = *(const PG8_LAS bf16x8*)(lds + PG8_SB(b, h) + boff + n * 2048 + k * 1024); } while (0)
#define PG8_MMA(ai, bj, At, Bt) do { __builtin_amdgcn_s_setprio(1); _Pragma("unroll") for (int m = 0; m < 4; ++m) _Pragma("unroll") for (int n = 0; n < 2; ++n) _Pragma("unroll") for (int k = 0; k < 2; ++k) \
        acc[ai][bj][m][n] = __builtin_amdgcn_mfma_f32_16x16x32_bf16(Bt[n][k], At[m][k], acc[ai][bj][m][n], 0, 0, 0); __builtin_amdgcn_s_setprio(0); } while (0)
#define PG8_WAIT_V(n) asm volatile("s_waitcnt vmcnt(" #n ")" ::: "memory")
#define PG8_WAIT_L(n) asm volatile("s_waitcnt lgkmcnt(" #n ")" ::: "memory")
#define PG8_BAR __builtin_amdgcn_s_barrier()
#define PG8_SCHED __builtin_amdgcn_sched_barrier(0)
    Unit cur, nxt; int ui = 0;
    if (!S.next(0, cur)) return;
    f32x4 acc[2][2][4][2];
#pragma unroll
    for (int a = 0; a < 2; ++a)
#pragma unroll
        for (int b = 0; b < 2; ++b)
#pragma unroll
            for (int m = 0; m < 4; ++m)
#pragma unroll
                for (int n = 0; n < 2; ++n) acc[a][b][m][n] = (f32x4){0.f, 0.f, 0.f, 0.f};
    bf16x8 At[4][2], B0[2][2], B1[2][2];
    const char* cA = (const char*)g.A + S.aoff(cur, tstep); const char* cB = (const char*)g.Bt + S.boff(cur, tstep);
    S.a_ready(cur);
    PG8_STAGE(PG8_SB(0, 0), cB, voffB); PG8_STAGE(PG8_SA(0, 0), cA, voffA); PG8_STAGE(PG8_SB(0, 1), cB + hstep, voffB); PG8_STAGE(PG8_SA(0, 1), cA + hstep, voffA);
    if (wr == 1) PG8_BAR;
    PG8_WAIT_V(4); PG8_BAR;
    PG8_STAGE(PG8_SB(1, 0), cB + kstep, voffB); PG8_STAGE(PG8_SA(1, 0), cA + kstep, voffA); PG8_STAGE(PG8_SB(1, 1), cB + hstep + kstep, voffB);
    PG8_WAIT_V(6); PG8_BAR;
    PG8_STAMP();
    for (;;) {
        const bool has_next = S.next(ui + 1, nxt);
        const char* nA = has_next ? (const char*)g.A + S.aoff(nxt, tstep) : cA; const char* nB = has_next ? (const char*)g.Bt + S.boff(nxt, tstep) : cB;
        for (int t = 0; t < nt; t += 2) {
            const bool last = (t == nt - 2);
            const char* a1 = cA + (size_t)(t + 1) * kstep;
            const char* a2 = last ? nA : cA + (size_t)(t + 2) * kstep; const char* b2 = last ? nB : cB + (size_t)(t + 2) * kstep;
            const char* a3 = a2 + kstep; const char* b3 = b2 + kstep;
            if (last && has_next) S.a_ready(nxt);
            PG8_LDB(B0, 0, 0); PG8_SCHED; PG8_LDA(At, 0, 0); PG8_STAGE(PG8_SA(1, 1), a1 + hstep, voffA);
            PG8_WAIT_L(8); PG8_BAR; PG8_WAIT_L(0); PG8_MMA(0, 0, At, B0); PG8_BAR; PG8_SCHED;
            PG8_LDB(B1, 0, 1); PG8_STAGE(PG8_SB(0, 0), b2, voffB);
            PG8_BAR; PG8_WAIT_L(0); PG8_MMA(0, 1, At, B1); PG8_BAR;
            PG8_LDA(At, 0, 1); PG8_STAGE(PG8_SA(0, 0), a2, voffA);
            PG8_BAR; PG8_WAIT_L(0); PG8_MMA(1, 0, At, B0); PG8_BAR; PG8_SCHED;
            PG8_STAGE(PG8_SB(0, 1), b2 + hstep, voffB);
            PG8_WAIT_V(6); PG8_BAR; PG8_MMA(1, 1, At, B1); PG8_BAR;
            PG8_LDB(B0, 1, 0); PG8_SCHED; PG8_LDA(At, 1, 0); PG8_STAGE(PG8_SA(0, 1), a2 + hstep, voffA);
            PG8_WAIT_L(8); PG8_BAR; PG8_WAIT_L(0); PG8_MMA(0, 0, At, B0); PG8_BAR; PG8_SCHED;
            PG8_LDB(B1, 1, 1); PG8_STAGE(PG8_SB(1, 0), b3, voffB);
            PG8_BAR; PG8_WAIT_L(0); PG8_MMA(0, 1, At, B1); PG8_BAR;
            PG8_LDA(At, 1, 1); PG8_STAGE(PG8_SA(1, 0), a3, voffA);
            PG8_BAR; PG8_WAIT_L(0); PG8_MMA(1, 0, At, B0); PG8_BAR; PG8_SCHED;
            PG8_STAGE(PG8_SB(1, 1), b3 + hstep, voffB);
            PG8_WAIT_V(6); PG8_BAR; PG8_MMA(1, 1, At, B1); PG8_BAR;
        }
        PG8_STAMP();
        if constexpr (!Epi::AFTER_DRAIN) { E(acc, cur, wr, wc, fr, fq); S.done(cur); }
        PG8_STAMP();
        if (!has_next) break;
#pragma unroll
        for (int a = 0; a < 2; ++a)
#pragma unroll
            for (int b = 0; b < 2; ++b)
#pragma unroll
                for (int m = 0; m < 4; ++m)
#pragma unroll
                    for (int n = 0; n < 2; ++n) acc[a][b][m][n] = (f32x4){0.f, 0.f, 0.f, 0.f};
        cur = nxt; cA = nA; cB = nB; ++ui;
    }
    PG8_WAIT_V(0);
    if (wr == 0) PG8_BAR;
    PG8_BAR;
    if constexpr (Epi::AFTER_DRAIN) { E.fused(acc, cur, wr, wc, fr, fq, lds, wid, lane); S.done(cur); }
    PG8_STAMP();
    if (STAMP && wid == 0) { stamps[lane] = lane < nts ? (((unsigned long long)(unsigned)ts_hi << 32) | (unsigned)ts_lo) : 0ull;
        if (lane == 62) stamps[62] = rt_entry; if (lane == 63) stamps[63] = (unsigned long long)wall_clock64(); }
#undef PG8_STAMP
#undef PG8_SA
#undef PG8_SB
#undef PG8_STAGE
#undef PG8_LDA
#undef PG8_LDB
#undef PG8_MMA
#undef PG8_WAIT_V
#undef PG8_WAIT_L
#undef PG8_BAR
#undef PG8_SCHED
}
}
#define XB_TMO      128
#define XB_XCNT(j)  (256  + 64 * (j))
#define XB_XSUB(j)  (1280 + 64 * (j))
#define XB_XGEN(j)  (2304 + 64 * (j))
#define XB_TOP      3328
#define XB_TOPGEN   3392
#define XCD_BAR_WORDS 3456
#define XB_SPIN_CAP (1u << 18)
#ifndef LAS
#define LAS __attribute__((address_space(3)))
#endif

__device__ __forceinline__ unsigned xb_ld(unsigned* p)              { return __hip_atomic_load(p, __ATOMIC_RELAXED, __HIP_MEMORY_SCOPE_AGENT); }
__device__ __forceinline__ unsigned xb_add(unsigned* p, unsigned v) { return __hip_atomic_fetch_add(p, v, __ATOMIC_RELAXED, __HIP_MEMORY_SCOPE_AGENT); }
__device__ __forceinline__ unsigned xb_xcc_id() { return (unsigned)__builtin_amdgcn_s_getreg((3 << 11) | 20) & 0xFu; }
#define XB_SPIN(cond, bar) do { unsigned _sp = 0; while (cond) { __builtin_amdgcn_s_sleep(1); \
    if ((++_sp & 255u) == 0u) { if (xb_ld(&(bar)[XB_TMO])) break; if (_sp > XB_SPIN_CAP) { atomicAdd(&(bar)[XB_TMO], 1u); break; } } } } while (0)

struct XcdBarrier {
    unsigned* bar; unsigned x;
    volatile LAS unsigned* st;
};

__device__ __forceinline__ XcdBarrier xcd_barrier_post(unsigned* bar, volatile LAS unsigned* st) {
    XcdBarrier b; b.bar = bar; b.x = xb_xcc_id(); b.st = st;
    if (threadIdx.x == 0) (void)xb_add(&bar[XB_XCNT(b.x)], 1u);
    return b;
}
__device__ __forceinline__ void xcd_barrier_complete(unsigned* bar, unsigned x, unsigned& nloc, unsigned& nx) {
    const unsigned G = gridDim.x * gridDim.y * gridDim.z;
    unsigned sum, cnt, mine, sp = 0u;
    for (;;) {
        sum = 0u; cnt = 0u; mine = 0u;
#pragma unroll
        for (unsigned j = 0; j < 16; ++j) { const unsigned c = xb_ld(&bar[XB_XCNT(j)]); sum += c; cnt += (c > 0u) ? 1u : 0u; mine = (j == x) ? c : mine; }
        if (sum == G) break;
        __builtin_amdgcn_s_sleep(1);
        if ((++sp & 255u) == 0u) { if (xb_ld(&bar[XB_TMO])) break; if (sp > XB_SPIN_CAP) { atomicAdd(&bar[XB_TMO], 1u); break; } }
    }
    nloc = mine > 0u ? mine : 1u; nx = cnt > 0u ? cnt : 1u;
}

__device__ __forceinline__ void xcd_barrier(const XcdBarrier& b) {
    asm volatile("s_waitcnt vmcnt(0)" ::: "memory");
    __syncthreads();
    if (threadIdx.x == 0) {
        unsigned* bar = b.bar;
        __builtin_amdgcn_s_waitcnt(0);
        unsigned nloc = b.st[0], nx = b.st[1];
        if (nloc == 0u) { xcd_barrier_complete(bar, b.x, nloc, nx); b.st[0] = nloc; b.st[1] = nx; }
        const unsigned old = xb_add(&bar[XB_XSUB(b.x)], 1u);
        const unsigned gen = old / nloc;
        if (old + 1u == (gen + 1u) * nloc) {
            __builtin_amdgcn_fence(__ATOMIC_RELEASE, "agent");
            asm volatile("s_waitcnt vmcnt(0)" ::: "memory");
            const unsigned og = xb_add(&bar[XB_TOP], 1u);
            const unsigned tg = og / nx;
            if (og + 1u == (tg + 1u) * nx) xb_add(&bar[XB_TOPGEN], 1u);
            else XB_SPIN(xb_ld(&bar[XB_TOPGEN]) == tg, bar);
            __builtin_amdgcn_fence(__ATOMIC_ACQUIRE, "agent");
            xb_add(&bar[XB_XGEN(b.x)], 1u);
            asm volatile("s_waitcnt vmcnt(0)" ::: "memory");
        } else {
            XB_SPIN(xb_ld(&bar[XB_XGEN(b.x)]) == gen, bar);
            __builtin_amdgcn_fence(__ATOMIC_ACQUIRE, "agent");
            asm volatile("s_waitcnt vmcnt(0)" ::: "memory");
        }
    }
    __syncthreads();
}


using pg8::bf16_t; using pg8::f32x4; using pg8::u32x4; using pg8::bf16x8;
typedef unsigned u32x2 __attribute__((ext_vector_type(2)));

constexpr int NB = 8, T = 4112, SEQ = 4096, NMETA = 16, D = 1024, FF = 2816;
constexpr int M = NB * T;
constexpr int MP = 33024;
constexpr int MMAIN = 32768;
constexpr int LDS_BYTES = 147456;
constexpr int LDF = 2880;
constexpr int PW = 2304;
#ifndef NREP_NORM
#define NREP_NORM 1
#endif
#ifndef STOP_AFTER
#define STOP_AFTER 99
#endif

struct Params { const float* in[27]; float* out; unsigned char* ws; float inv[8]; };

constexpr size_t SZ_H = (size_t)MP * D * 4, SZ_B16 = (size_t)MP * D * 2;
constexpr size_t OFF_H = 0, OFF_WB = OFF_H + SZ_H, SZ_WB = (size_t)20 << 20, OFF_R = OFF_WB + SZ_WB;
constexpr size_t OFF_XN = OFF_R, OFF_ACT = OFF_R + SZ_B16;
constexpr size_t OFF_AP = OFF_R, OFF_E = OFF_R, OFF_ASIG = OFF_R + SZ_B16, OFF_RKV = OFF_R + 2 * SZ_B16;
constexpr size_t SZ_L1 = (size_t)MP * 256 * 2;
constexpr size_t OFF_BAR = (size_t)500 << 20;
constexpr size_t OFF_PART = (size_t)501 << 20;
constexpr size_t OFF_HN = OFF_R, OFF_P = OFF_R + SZ_B16, OFF_TAB = OFF_P + (size_t)MP * PW * 2;
constexpr size_t OFF_Q8 = OFF_TAB + ((size_t)1 << 20);
constexpr size_t OFF_K8 = OFF_Q8 + (size_t)MP * 1024;
static_assert(OFF_K8 + (size_t)MP * 256 <= OFF_BAR, "ws");
constexpr size_t WB_W1T = 0, WB_W2T = (size_t)5632 * 1024 * 2;
static_assert(WB_W2T + (size_t)1024 * LDF * 2 <= ((size_t)20 << 20), "wb");
constexpr size_t WB_WPT = 0, WB_L2W = (size_t)3840 * 2048 * 2, WB_RWO = WB_L2W + 3 * (size_t)1024 * 256 * 2;
constexpr size_t WB_WIT = 0, WB_AWO = (size_t)PW * 1024 * 2;
static_assert(OFF_RKV + 3 * SZ_B16 <= ((size_t)512 << 20), "ws");
static_assert(OFF_ACT + (size_t)MP * LDF * 2 <= ((size_t)500 << 20), "ws");
static_assert(WB_RWO + (size_t)1024 * 1024 * 2 <= SZ_WB, "wb");

__device__ __forceinline__ unsigned pk2(float a, float b) { return pg8::cvt_pk_bf16(a, b); }
__device__ __forceinline__ float bf_lo(unsigned u) { return __uint_as_float(u << 16); }
__device__ __forceinline__ float bf_hi(unsigned u) { return __uint_as_float(u & 0xffff0000u); }
__device__ __forceinline__ unsigned short f2h(float x) { _Float16 h = (_Float16)x; return __builtin_bit_cast(unsigned short, h); }
__device__ __forceinline__ float h2f(unsigned short u) { return (float)__builtin_bit_cast(_Float16, u); }
__device__ __forceinline__ void lds_wave_sync() { asm volatile("s_waitcnt lgkmcnt(0)" ::: "memory"); }
__device__ __forceinline__ float wave_sum(float v) {
#pragma unroll
    for (int o = 1; o < 64; o <<= 1) v += __shfl_xor(v, o);
    return v;
}
template <int CTRL> __device__ __forceinline__ float dppmov(float v) {
    return __builtin_bit_cast(float, __builtin_amdgcn_update_dpp(0, __builtin_bit_cast(int, v), CTRL, 0xF, 0xF, true));
}
__device__ __forceinline__ float row16_sum(float v) { v += dppmov<0xB1>(v); v += dppmov<0x4E>(v); v += dppmov<0x141>(v); v += dppmov<0x140>(v); return v; }
__device__ __forceinline__ float row16_max(float v) { v = fmaxf(v, dppmov<0xB1>(v)); v = fmaxf(v, dppmov<0x4E>(v)); v = fmaxf(v, dppmov<0x141>(v)); v = fmaxf(v, dppmov<0x140>(v)); return v; }
__device__ __forceinline__ float sigmoidf_(float x) { return 1.0f / (1.0f + __expf(-x)); }

__device__ __forceinline__ void tr_job(const float* W, int Ksrc, int Nsrc, int ldn, const float* kscale, int perm,
                                       bf16_t* WT, int ldk, int drow0, int dk0, int Npad, int Kpad, float* scr, int gw, int ngw, int lane, int& rot) {
    const int nblk = Npad / 32, nitems = (Kpad / 64) * nblk;
    const int first = (gw >= rot) ? (gw - rot) : (gw + ngw - rot);
    rot = (rot + nitems) % ngw;
    for (int it = first; it < nitems; it += ngw) {
        const int kb = it / nblk, nb = it % nblk, k0 = 64 * kb, n0 = 32 * nb;
        int ns0 = n0;
        if (perm) { const int pn = n0 >> 8, w = n0 & 255; ns0 = (w < 128) ? (128 * pn + w) : (FF + 128 * pn + (w - 128)); }
#pragma unroll 16
        for (int i = 0; i < 32; ++i) {
            const int kk = 2 * i + (lane >> 5), k = k0 + kk, n = ns0 + (lane & 31);
            float v = 0.f;
            if (k < Ksrc && n < Nsrc) { v = W[(size_t)k * ldn + n]; if (kscale) v *= kscale[k]; }
            scr[kk * 33 + (lane & 31)] = v;
        }
        lds_wave_sync();
        const int c = lane & 7;
#pragma unroll
        for (int j = 0; j < 4; ++j) {
            const int n = (lane >> 3) + 8 * j; const float* s = scr + (8 * c) * 33 + n;
            u32x4 o; o.x = pk2(s[0 * 33], s[1 * 33]); o.y = pk2(s[2 * 33], s[3 * 33]); o.z = pk2(s[4 * 33], s[5 * 33]); o.w = pk2(s[6 * 33], s[7 * 33]);
            *(u32x4*)(WT + (size_t)(drow0 + n0 + n) * ldk + dk0 + k0 + 8 * c) = o;
        }
        lds_wave_sync();
    }
}

template <int MODE>
__device__ __forceinline__ void norm_phase(const Params& p, const float* g, float* H, bf16_t* OUT, int gw, int ngw, int lane, const float* PART = nullptr, int ns = 0) {
    constexpr int LDO = (MODE == 2) ? 2 * D : D;
    constexpr int NR = (MODE == 2) ? 2 : 4;
    f32x4 gv[4];
#pragma unroll
    for (int j = 0; j < 4; ++j) gv[j] = *(const f32x4*)(g + 4 * (lane + 64 * j));
    for (int r0 = gw; r0 < MP; r0 += NR * ngw) {
        f32x4 v[NR][4], pv[NR][4];
        int rr[NR], tt[NR];
#pragma unroll
        for (int q = 0; q < NR; ++q) {
            const int r = r0 + q * ngw; rr[q] = r;
            const int rc = (r < M) ? r : 0;
            const int b = rc / T, t = rc - b * T; tt[q] = t;
            const float* src;
            if (MODE == 1) src = (t < NMETA) ? (p.in[1] + (size_t)t * D) : (p.in[0] + ((size_t)b * SEQ + (t - NMETA)) * D);
            else src = H + (size_t)rc * D;
#pragma unroll
            for (int j = 0; j < 4; ++j) v[q][j] = *(const f32x4*)(src + 4 * (lane + 64 * j));
            if (MODE == 0 && ns > 0 && r >= MMAIN && r < M) {
                for (int s = 0; s < ns; ++s)
#pragma unroll
                    for (int j = 0; j < 4; ++j) v[q][j] = v[q][j] + *(const f32x4*)(PART + ((size_t)s * (M - MMAIN) + (r - MMAIN)) * D + 4 * (lane + 64 * j));
#pragma unroll
                for (int j = 0; j < 4; ++j) *(f32x4*)(H + (size_t)r * D + 4 * (lane + 64 * j)) = v[q][j];
            }
            if (MODE == 2) {
                const float* ps = H + (size_t)(rc > 0 ? rc - 1 : 0) * D;
#pragma unroll
                for (int j = 0; j < 4; ++j) pv[q][j] = *(const f32x4*)(ps + 4 * (lane + 64 * j));
            }
        }
#pragma unroll
        for (int q = 0; q < NR; ++q) {
            const int r = rr[q];
            if (r >= MP) continue;
            bf16_t* orow = OUT + (size_t)r * LDO;
            if (r >= M) {
#pragma unroll
                for (int j = 0; j < 4; ++j) { *(u32x2*)(orow + 4 * (lane + 64 * j)) = (u32x2){0u, 0u}; if (MODE == 2) *(u32x2*)(orow + D + 4 * (lane + 64 * j)) = (u32x2){0u, 0u}; }
                continue;
            }
            float ss = 0.f;
#pragma unroll
            for (int j = 0; j < 4; ++j) ss += v[q][j].x * v[q][j].x + v[q][j].y * v[q][j].y + v[q][j].z * v[q][j].z + v[q][j].w * v[q][j].w;
            if (MODE == 1) {
#pragma unroll
                for (int j = 0; j < 4; ++j) *(f32x4*)(H + (size_t)r * D + 4 * (lane + 64 * j)) = v[q][j];
            }
            const float rstd = 1.0f / sqrtf(wave_sum(ss) * (1.0f / D) + 1e-6f);
#pragma unroll
            for (int j = 0; j < 4; ++j) v[q][j] = v[q][j] * rstd * gv[j];
            if (MODE == 2) {
                if (tt[q] > 0) {
                    float s2 = 0.f;
#pragma unroll
                    for (int j = 0; j < 4; ++j) s2 += pv[q][j].x * pv[q][j].x + pv[q][j].y * pv[q][j].y + pv[q][j].z * pv[q][j].z + pv[q][j].w * pv[q][j].w;
                    const float rp = 1.0f / sqrtf(wave_sum(s2) * (1.0f / D) + 1e-6f);
#pragma unroll
                    for (int j = 0; j < 4; ++j) pv[q][j] = pv[q][j] * rp * gv[j];
                } else {
#pragma unroll
                    for (int j = 0; j < 4; ++j) pv[q][j] = (f32x4){0.f, 0.f, 0.f, 0.f};
                }
#pragma unroll
                for (int j = 0; j < 4; ++j) { const f32x4 xx = pv[q][j] - v[q][j]; *(u32x2*)(orow + D + 4 * (lane + 64 * j)) = (u32x2){pk2(xx.x, xx.y), pk2(xx.z, xx.w)}; }
            }
#pragma unroll
            for (int j = 0; j < 4; ++j) *(u32x2*)(orow + 4 * (lane + 64 * j)) = (u32x2){pk2(v[q][j].x, v[q][j].y), pk2(v[q][j].z, v[q][j].w)};
        }
    }
}

struct EpiSwiGLU {
    static constexpr bool PERM = true, AFTER_DRAIN = false;
    bf16_t* O;
    __device__ __forceinline__ void operator()(const f32x4 (&acc)[2][2][4][2], const pg8::Unit& u, int wr, int wc, int fr, int fq) const {
        const int row0 = u.pm * 256 + wr * 64 + fr, col0 = u.pn * 128 + wc * 32 + 8 * fq;
#pragma unroll
        for (int ai = 0; ai < 2; ++ai)
#pragma unroll
            for (int m = 0; m < 4; ++m) {
                bf16_t* rowp = O + (size_t)(row0 + ai * 128 + m * 16) * LDF + col0;
                float o[8];
#pragma unroll
                for (int n = 0; n < 2; ++n)
#pragma unroll
                    for (int j = 0; j < 4; ++j) { const float gte = acc[ai][0][m][n][j], up = acc[ai][1][m][n][j]; o[4 * n + j] = gte * __builtin_amdgcn_rcpf(1.0f + __expf(-gte)) * up; }
                u32x4 w; w.x = pk2(o[0], o[1]); w.y = pk2(o[2], o[3]); w.z = pk2(o[4], o[5]); w.w = pk2(o[6], o[7]);
                *(u32x4*)rowp = w;
            }
    }
};
template <bool FINAL> struct EpiResid {
    static constexpr bool PERM = false, AFTER_DRAIN = false;
    float* H; float scale; float* out;
    __device__ __forceinline__ void operator()(const f32x4 (&acc)[2][2][4][2], const pg8::Unit& u, int wr, int wc, int fr, int fq) const {
        const int row0 = u.pm * 256 + wr * 64 + fr, col0 = u.pn * 256 + wc * 32 + 4 * fq;
#pragma unroll
        for (int ai = 0; ai < 2; ++ai)
#pragma unroll
            for (int m = 0; m < 4; ++m) {
                const int row = row0 + ai * 128 + m * 16;
                if (row < M) {
                    float* hp = H + (size_t)row * D + col0;
                    const int b = row / T, t = row - b * T;
                    float* op = FINAL ? (out + ((size_t)b * SEQ + (t - NMETA)) * D + col0) : nullptr;
#pragma unroll
                    for (int bj = 0; bj < 2; ++bj)
#pragma unroll
                        for (int n = 0; n < 2; ++n) {
                            f32x4 hv = *(const f32x4*)(hp + bj * 128 + n * 16); hv = hv + acc[ai][bj][m][n] * scale;
                            if (FINAL) { if (t >= NMETA) *(f32x4*)(op + bj * 128 + n * 16) = hv; }
                            else *(f32x4*)(hp + bj * 128 + n * 16) = hv;
                        }
                }
            }
    }
};
template <int mode> struct EpiBf {
    static constexpr bool PERM = true, AFTER_DRAIN = false;
    bf16_t* O0; bf16_t* O1; const float* bias; int ldo;
    template <int ACT> __device__ __forceinline__ void body(const f32x4 (&acc)[2][2][4][2], bf16_t* base, int ld, int row0, int col0) const {
#pragma unroll
        for (int ai = 0; ai < 2; ++ai)
#pragma unroll
            for (int m = 0; m < 4; ++m)
#pragma unroll
                for (int bj = 0; bj < 2; ++bj) {
                    bf16_t* rowp = base + (size_t)(row0 + ai * 128 + m * 16) * ld + col0 + bj * 128;
                    f32x4 v0 = acc[ai][bj][m][0] + (f32x4){0.f, 0.f, 0.f, 0.f}, v1 = acc[ai][bj][m][1] + (f32x4){0.f, 0.f, 0.f, 0.f};
                    if (mode >= 2) { v0 = v0 + *(const f32x4*)(bias + col0 + bj * 128); v1 = v1 + *(const f32x4*)(bias + col0 + bj * 128 + 4); }
#pragma unroll
                    for (int j = 0; j < 4; ++j) {
                        if (ACT == 1) { v0[j] = 1.0f - 2.0f / (__expf(2.0f * v0[j]) + 1.0f); v1[j] = 1.0f - 2.0f / (__expf(2.0f * v1[j]) + 1.0f); }
                        if (ACT == 2) { v0[j] = sigmoidf_(v0[j]); v1[j] = sigmoidf_(v1[j]); }
                        if (ACT == 3) { v0[j] = 0.6065306597f * sigmoidf_(v0[j]); v1[j] = 0.6065306597f * sigmoidf_(v1[j]); }
                    }
                    u32x4 w;
#ifdef PKRTZ
                    if (ACT == 3) { typedef _Float16 h2_ __attribute__((ext_vector_type(2))); h2_ q0 = __builtin_amdgcn_cvt_pkrtz(v0[0], v0[1]), q1 = __builtin_amdgcn_cvt_pkrtz(v0[2], v0[3]), q2 = __builtin_amdgcn_cvt_pkrtz(v1[0], v1[1]), q3 = __builtin_amdgcn_cvt_pkrtz(v1[2], v1[3]);
                        w.x = __builtin_bit_cast(unsigned, q0); w.y = __builtin_bit_cast(unsigned, q1); w.z = __builtin_bit_cast(unsigned, q2); w.w = __builtin_bit_cast(unsigned, q3); } else
#endif
                    if (ACT == 3) {
                        w.x = f2h(v0[0]) | ((unsigned)f2h(v0[1]) << 16); w.y = f2h(v0[2]) | ((unsigned)f2h(v0[3]) << 16);
                        w.z = f2h(v1[0]) | ((unsigned)f2h(v1[1]) << 16); w.w = f2h(v1[2]) | ((unsigned)f2h(v1[3]) << 16);
                    } else { w.x = pk2(v0[0], v0[1]); w.y = pk2(v0[2], v0[3]); w.z = pk2(v1[0], v1[1]); w.w = pk2(v1[2], v1[3]); }
                    *(u32x4*)rowp = w;
                }
    }
    __device__ __forceinline__ void operator()(const f32x4 (&acc)[2][2][4][2], const pg8::Unit& u, int wr, int wc, int fr, int fq) const {
        const int row0 = u.pm * 256 + wr * 64 + fr, cl = wc * 32 + 8 * fq;
        if (mode == 1) {
            if (u.pn < 12) body<0>(acc, O0 + (size_t)(u.pn >> 2) * ((size_t)MP * D), D, row0, (u.pn & 3) * 256 + cl);
            else if (u.pn == 12) body<1>(acc, O1, 256, row0, cl);
            else if (u.pn == 13) body<0>(acc, O1 + (size_t)MP * 256, 256, row0, cl);
            else body<2>(acc, O1 + (size_t)2 * MP * 256, 256, row0, cl);
        } else if (mode == 2) body<3>(acc, O0, ldo, row0, u.pn * 256 + cl);
        else if (mode == 3) body<2>(acc, O0, ldo, row0, u.pn * 256 + cl);
        else body<0>(acc, O0, ldo, row0, u.pn * 256 + cl);
    }
};

template <class Epi>
__device__ __forceinline__ void run_gemm(unsigned char* smem, const bf16_t* A, const bf16_t* Bt, int N, int K, const Epi E, int rot, int Mrows = MP, int ld = 0) {
    pg8::Gemm g; g.A = A; g.Bt = Bt; g.M = Mrows; g.N = N; g.K = K; g.ld = ld ? ld : K;
    pg8::StaticOrder S; S.init(Mrows, N, (int)gridDim.x, (int)((blockIdx.x + rot) % gridDim.x));
    pg8::gemm_phase<Epi, pg8::StaticOrder, false>((PG8_LAS unsigned char*)smem, g, S, E, nullptr);
    __syncthreads();
}

struct EpiTailPart {
    static constexpr bool PERM = false, AFTER_DRAIN = false;
    float* PART; float scale;
    __device__ __forceinline__ void operator()(const f32x4 (&acc)[2][2][4][2], const pg8::Unit& u, int wr, int wc, int fr, int fq) const {
        const int lrow0 = wr * 64 + fr, col0 = (u.pn & 3) * 256 + wc * 32 + 4 * fq;
        float* base = PART + (size_t)(u.pn >> 2) * ((size_t)(M - MMAIN) * D);
#pragma unroll
        for (int m = 0; m < 4; ++m) {
            const int lrow = lrow0 + m * 16;
            if (lrow < M - MMAIN) {
                float* hp = base + (size_t)lrow * D + col0;
#pragma unroll
                for (int bj = 0; bj < 2; ++bj)
#pragma unroll
                    for (int n = 0; n < 2; ++n) *(f32x4*)(hp + bj * 128 + n * 16) = acc[0][bj][m][n] * scale;
            }
        }
    }
};
__device__ __forceinline__ void run_gemm_tail(unsigned char* smem, const bf16_t* A, const bf16_t* Bt, int K, float* PART, float scale, int rot, int ld = 0) {
    if (!ld) ld = K;
    pg8::Gemm g; g.A = A + (size_t)MMAIN * ld; g.Bt = Bt; g.M = 256; g.N = D; g.K = 256; g.ld = ld;
    pg8::SplitKOrder S; S.init(4, K / 256, (int)gridDim.x, (int)((blockIdx.x + rot) % gridDim.x));
    EpiTailPart E; E.PART = PART; E.scale = scale;
    pg8::gemm_phase<EpiTailPart, pg8::SplitKOrder, false>((PG8_LAS unsigned char*)smem, g, S, E, nullptr);
    __syncthreads();
}

constexpr int SC_STEP = 356, SC_TC = 32;
__device__ __forceinline__ void scan_phase(const Params& p, unsigned char* ws, bf16_t* Y, unsigned char* smem) {
    float* buf = (float*)smem;
    float* ybuf = (float*)(smem + 2 * SC_TC * SC_STEP * 4);
    const bf16_t* Rr = (const bf16_t*)(ws + OFF_RKV); const bf16_t* Kr = Rr + (size_t)MP * D; const bf16_t* Vr = Kr + (size_t)MP * D;
    const bf16_t* As = (const bf16_t*)(ws + OFF_ASIG); const bf16_t* Eh = (const bf16_t*)(ws + OFF_E);
    int tid = threadIdx.x; asm volatile("" : "+v"(tid));
    const bool is_comp = tid < 256;
    const int sub = tid & 15, grp = (tid >> 4) & 15;
    constexpr int NCH = (T + SC_TC - 1) / SC_TC;
    typedef float f32x2_ __attribute__((ext_vector_type(2)));
    for (int item = blockIdx.x; item < 256; item += gridDim.x) {
        const int b = item >> 5, h = (item >> 1) & 15, half = item & 1;
        const int cb = h * 64 + 4 * sub;
        f32x4 kkc, kac, w0c, a0c;
        if (!is_comp) { kkc = *(const f32x4*)(p.in[18] + cb); kac = *(const f32x4*)(p.in[19] + cb); w0c = *(const f32x4*)(p.in[10] + cb); a0c = *(const f32x4*)(p.in[13] + cb); }
        auto stage2 = [&](int c, float* dstb) {
            u32x2 pr[2], pk[2], pa[2], pe[2], pv[2];
#pragma unroll
            for (int q = 0; q < 2; ++q) {
                const int t = c * SC_TC + grp + 16 * q;
                pr[q] = (u32x2){0u, 0u}; pk[q] = pr[q]; pa[q] = pr[q]; pe[q] = pr[q]; pv[q] = pr[q];
                if (t < T) {
                    const size_t ro = ((size_t)b * T + t) * D;
                    pr[q] = *(const u32x2*)(Rr + ro + cb); pk[q] = *(const u32x2*)(Kr + ro + cb); pa[q] = *(const u32x2*)(As + ro + cb); pe[q] = *(const u32x2*)(Eh + ro + cb);
                    if (sub < 8) pv[q] = *(const u32x2*)(Vr + ro + h * 64 + half * 32 + 4 * sub);
                }
            }
#pragma unroll
            for (int q = 0; q < 2; ++q) {
                float* sp = dstb + (grp + 16 * q) * SC_STEP;
                const f32x4 r4 = (f32x4){bf_lo(pr[q].x), bf_hi(pr[q].x), bf_lo(pr[q].y), bf_hi(pr[q].y)};
                const f32x4 k4 = (f32x4){bf_lo(pk[q].x), bf_hi(pk[q].x), bf_lo(pk[q].y), bf_hi(pk[q].y)};
                f32x4 a4 = (f32x4){bf_lo(pa[q].x), bf_hi(pa[q].x), bf_lo(pa[q].y), bf_hi(pa[q].y)} + a0c;
                a4.x = sigmoidf_(a4.x); a4.y = sigmoidf_(a4.y); a4.z = sigmoidf_(a4.z); a4.w = sigmoidf_(a4.w);
                f32x4 e4 = (f32x4){bf_lo(pe[q].x), bf_hi(pe[q].x), bf_lo(pe[q].y), bf_hi(pe[q].y)} + w0c;
                e4.x = 0.6065306597f * sigmoidf_(e4.x); e4.y = 0.6065306597f * sigmoidf_(e4.y); e4.z = 0.6065306597f * sigmoidf_(e4.z); e4.w = 0.6065306597f * sigmoidf_(e4.w);
                f32x4 kk = k4 * kkc;
                const float ss = row16_sum(kk.x * kk.x + kk.y * kk.y + kk.z * kk.z + kk.w * kk.w);
                const float inv = 1.0f / fmaxf(sqrtf(ss), 1e-12f);
                kk = kk * inv;
                const f32x4 kf = k4 * (1.0f + (a4 - 1.0f) * kac);
                f32x4 w; w.x = __expf(-e4.x); w.y = __expf(-e4.y); w.z = __expf(-e4.z); w.w = __expf(-e4.w);
                const f32x4 Bv = kk * a4, WR = w * r4;
                const float br = row16_sum(Bv.x * r4.x + Bv.y * r4.y + Bv.z * r4.z + Bv.w * r4.w);
                const float kr = row16_sum(kf.x * r4.x + kf.y * r4.y + kf.z * r4.z + kf.w * r4.w);
                *(f32x4*)(sp + 4 * sub) = -kk; *(f32x4*)(sp + 64 + 4 * sub) = WR; *(f32x4*)(sp + 128 + 4 * sub) = w; *(f32x4*)(sp + 192 + 4 * sub) = Bv; *(f32x4*)(sp + 256 + 4 * sub) = kf;
                if (sub < 8) *(f32x4*)(sp + 320 + 4 * sub) = (f32x4){bf_lo(pv[q].x), bf_hi(pv[q].x), bf_lo(pv[q].y), bf_hi(pv[q].y)};
                if (sub == 0) { sp[352] = br; sp[353] = kr; }
            }
        };
        auto yout = [&](int c) {
            const int st = (tid - 256) >> 3, r4i = (tid & 7) * 4, t = c * SC_TC + st;
            if (t < T) {
                const f32x4 yv = *(const f32x4*)(ybuf + (c & 1) * (SC_TC * 32) + st * 32 + r4i);
                *(u32x2*)(Y + ((size_t)b * T + t) * D + h * 64 + half * 32 + r4i) = (u32x2){pk2(yv.x, yv.y), pk2(yv.z, yv.w)};
            }
        };
        if (!is_comp) stage2(0, buf);
        __syncthreads();
        f32x2_ Sa01 = (f32x2_){0.f, 0.f}, Sa23 = Sa01, Sb01 = Sa01, Sb23 = Sa01;
        for (int c = 0; c < NCH; ++c) {
            if (is_comp) {
                const int nst = (T - c * SC_TC) < SC_TC ? (T - c * SC_TC) : SC_TC;
                const float* cbuf = buf + (c & 1) * (SC_TC * SC_STEP); float* yb = ybuf + (c & 1) * (SC_TC * 32);
#define SC_LDO(X, s_) do { const float* sp_ = cbuf + (s_) * SC_STEP; \
                    A4##X = *(const f32x4*)(sp_ + 4 * sub); WR4##X = *(const f32x4*)(sp_ + 64 + 4 * sub); W4##X = *(const f32x4*)(sp_ + 128 + 4 * sub); \
                    B4##X = *(const f32x4*)(sp_ + 192 + 4 * sub); K4##X = *(const f32x4*)(sp_ + 256 + 4 * sub); \
                    via##X = sp_[320 + grp]; vib##X = sp_[336 + grp]; bk##X = *(const f32x2_*)(sp_ + 352); } while (0)
#define SC_STEPF(X, s_) do { \
                    const f32x2_ A01 = (f32x2_){A4##X.x, A4##X.y}, A23 = (f32x2_){A4##X.z, A4##X.w}, R01 = (f32x2_){WR4##X.x, WR4##X.y}, R23 = (f32x2_){WR4##X.z, WR4##X.w}; \
                    const f32x2_ sa2 = Sa01 * A01 + Sa23 * A23, sb2 = Sb01 * A01 + Sb23 * A23; \
                    const f32x2_ ya2 = Sa01 * R01 + Sa23 * R23, yb2 = Sb01 * R01 + Sb23 * R23; \
                    const float sa = row16_sum(sa2.x + sa2.y), sb = row16_sum(sb2.x + sb2.y), ypa = row16_sum(ya2.x + ya2.y), ypb = row16_sum(yb2.x + yb2.y); \
                    const f32x2_ W01 = (f32x2_){W4##X.x, W4##X.y}, W23 = (f32x2_){W4##X.z, W4##X.w}, B01 = (f32x2_){B4##X.x, B4##X.y}, B23 = (f32x2_){B4##X.z, B4##X.w}, K01 = (f32x2_){K4##X.x, K4##X.y}, K23 = (f32x2_){K4##X.z, K4##X.w}; \
                    const f32x2_ sav = (f32x2_){sa, sa}, sbv = (f32x2_){sb, sb}, vav = (f32x2_){via##X, via##X}, vbv = (f32x2_){vib##X, vib##X}; \
                    Sa01 = Sa01 * W01 + (sav * B01 + vav * K01); Sa23 = Sa23 * W23 + (sav * B23 + vav * K23); \
                    Sb01 = Sb01 * W01 + (sbv * B01 + vbv * K01); Sb23 = Sb23 * W23 + (sbv * B23 + vbv * K23); \
                    if (sub == 0) { yb[(s_) * 32 + grp] = ypa + sa * bk##X.x + via##X * bk##X.y; yb[(s_) * 32 + 16 + grp] = ypb + sb * bk##X.x + vib##X * bk##X.y; } } while (0)
                f32x4 A4a, WR4a, W4a, B4a, K4a, A4b, WR4b, W4b, B4b, K4b; float viaa, viba, viab, vibb; f32x2_ bka, bkb;
                SC_LDO(a, 0);
                for (int s = 0; s < nst; s += 2) {
                    SC_LDO(b, s + 1);
                    SC_STEPF(a, s);
                    if (s + 2 < nst) SC_LDO(a, s + 2);
                    SC_STEPF(b, s + 1);
                }
            } else {
                if (c > 0) yout(c - 1);
                if (c + 1 < NCH) stage2(c + 1, buf + ((c + 1) & 1) * (SC_TC * SC_STEP));
            }
            __syncthreads();
        }
        if (!is_comp) yout(NCH - 1);
        __syncthreads();
    }
}

__device__ __forceinline__ void rwkv_post_phase(const Params& p, unsigned char* ws, bf16_t* Y, int gw, int ngw, int lane) {
    const bf16_t* Rr = (const bf16_t*)(ws + OFF_RKV); const bf16_t* Kr = Rr + (size_t)MP * D; const bf16_t* Vr = Kr + (size_t)MP * D;
    const bf16_t* As = (const bf16_t*)(ws + OFF_ASIG); const bf16_t* G = (const bf16_t*)(ws + OFF_E);
    const int grp = lane >> 4, sub = lane & 15;
    constexpr int NI = 4;
    for (int w0 = gw; w0 < MP * 4; w0 += NI * ngw) {
        u32x2 uy[NI], ur[NI], uk[NI], uv[NI], ua[NI], ug[NI]; size_t os[NI]; int c0s[NI], st[NI];
#pragma unroll
        for (int i = 0; i < NI; ++i) {
            const int w = w0 + i * ngw, wc = (w < MP * 4) ? w : w0;
            const int row = wc >> 2, q = wc & 3; c0s[i] = (q * 4 + grp) * 64 + 4 * sub; os[i] = (size_t)row * D + c0s[i];
            st[i] = (w >= MP * 4) ? 2 : ((row >= M) ? 1 : 0);
            const size_t o = (row >= M) ? (size_t)c0s[i] : os[i];
            uy[i] = *(const u32x2*)(Y + o); ur[i] = *(const u32x2*)(Rr + o); uk[i] = *(const u32x2*)(Kr + o); uv[i] = *(const u32x2*)(Vr + o); ua[i] = *(const u32x2*)(As + o); ug[i] = *(const u32x2*)(G + o);
        }
#pragma unroll
        for (int i = 0; i < NI; ++i) {
            const int c0 = c0s[i];
            const f32x4 y = (f32x4){bf_lo(uy[i].x), bf_hi(uy[i].x), bf_lo(uy[i].y), bf_hi(uy[i].y)}, r = (f32x4){bf_lo(ur[i].x), bf_hi(ur[i].x), bf_lo(ur[i].y), bf_hi(ur[i].y)};
            const f32x4 k = (f32x4){bf_lo(uk[i].x), bf_hi(uk[i].x), bf_lo(uk[i].y), bf_hi(uk[i].y)}, v = (f32x4){bf_lo(uv[i].x), bf_hi(uv[i].x), bf_lo(uv[i].y), bf_hi(uv[i].y)};
            f32x4 a = (f32x4){bf_lo(ua[i].x), bf_hi(ua[i].x), bf_lo(ua[i].y), bf_hi(ua[i].y)} + *(const f32x4*)(p.in[13] + c0);
            a.x = sigmoidf_(a.x); a.y = sigmoidf_(a.y); a.z = sigmoidf_(a.z); a.w = sigmoidf_(a.w);
            const f32x4 g = (f32x4){bf_lo(ug[i].x), bf_hi(ug[i].x), bf_lo(ug[i].y), bf_hi(ug[i].y)};
            const f32x4 kac = *(const f32x4*)(p.in[19] + c0), rkc = *(const f32x4*)(p.in[20] + c0), lg = *(const f32x4*)(p.in[21] + c0), lb = *(const f32x4*)(p.in[22] + c0);
            const f32x4 kf = k * (1.0f + (a - 1.0f) * kac);
            const f32x4 t3 = r * kf * rkc;
            const float rk = row16_sum(t3.x + t3.y + t3.z + t3.w);
            const float mu = row16_sum(y.x + y.y + y.z + y.w) * (1.0f / 64.0f);
            const f32x4 dlt = y - mu;
            const float var = row16_sum(dlt.x * dlt.x + dlt.y * dlt.y + dlt.z * dlt.z + dlt.w * dlt.w) * (1.0f / 64.0f);
            const float rs = 1.0f / sqrtf(var + 64e-5f);
            const f32x4 z = ((dlt * rs) * lg + lb + v * rk) * g;
            if (st[i] == 0) *(u32x2*)(Y + os[i]) = (u32x2){pk2(z.x, z.y), pk2(z.z, z.w)};
            else if (st[i] == 1) *(u32x2*)(Y + os[i]) = (u32x2){0u, 0u};
        }
    }
}

__device__ __forceinline__ void rope_table_phase(const Params& p, float* TAB, int gtid, int ngt) {
    for (int i = gtid; i < T * 8; i += ngt) {
        const int t = i >> 3, k = i & 7;
        const float ang = (float)t * p.inv[k];
        double rev = (double)ang * 0.15915494309189535; rev -= rint(rev);
        const float rf = (float)rev;
        TAB[t * 16 + k] = __builtin_amdgcn_cosf(rf); TAB[t * 16 + 8 + k] = __builtin_amdgcn_sinf(rf);
    }
}
__device__ __forceinline__ void attn_post_phase(const Params& p, bf16_t* P, const float* TAB, unsigned char* Q8, unsigned char* K8, int gw, int ngw, int lane) {
    const int grp = lane >> 4, sub = lane & 15;
    const f32x4 qg = *(const f32x4*)(p.in[24] + 4 * sub), kg = *(const f32x4*)(p.in[25] + 4 * sub);
    constexpr int NI = 8;
    for (int w0 = gw; w0 < M * 8; w0 += NI * ngw) {
        u32x2 raw[NI]; bf16_t* ptrs[NI]; int us[NI], ts[NI];
#pragma unroll
        for (int i = 0; i < NI; ++i) {
            const int w = w0 + i * ngw, wc = (w < M * 8) ? w : w0;
            const int row = wc >> 3; int q4 = wc & 7; if (q4 >= 5) q4 += 1;
            us[i] = (w < M * 8) ? (4 * q4 + grp) : 99; ts[i] = row % T;
            ptrs[i] = P + (size_t)row * PW + 64 * (4 * q4 + grp) + 4 * sub;
            raw[i] = *(const u32x2*)ptrs[i];
        }
#pragma unroll
        for (int i = 0; i < NI; ++i) {
            const int u = us[i], t = ts[i];
            f32x4 x = (f32x4){bf_lo(raw[i].x), bf_hi(raw[i].x), bf_lo(raw[i].y), bf_hi(raw[i].y)};
            const bool isq = u < 16, isk = (u >= 16) && (u < 20), dorope = (u < 20) || (u >= 24 && u <= 32);
            const float ss = row16_sum(x.x * x.x + x.y * x.y + x.z * x.z + x.w * x.w) * (1.0f / 64.0f);
            if (isq || isk) { const float rs = 1.0f / sqrtf(ss + 1e-6f); x = x * rs * (isq ? qg : kg); }
            f32x4 xp; xp.x = dppmov<0x4E>(x.x); xp.y = dppmov<0x4E>(x.y); xp.z = dppmov<0x4E>(x.z); xp.w = dppmov<0x4E>(x.w);
            if (dorope && sub < 4) {
                const float* tb = TAB + t * 16 + (sub & 1) * 4;
                const f32x4 c = *(const f32x4*)tb, s = *(const f32x4*)(tb + 8);
                x = (sub < 2) ? (x * c - xp * s) : (x * c + xp * s);
            }
            if (u == 33) { if (sub < 2) x = x * 0.04419417382f; }
            if (u < 34) *(u32x2*)ptrs[i] = (u32x2){pk2(x.x, x.y), pk2(x.z, x.w)};
            if (u < 20) {
                int w8 = __builtin_amdgcn_cvt_pk_fp8_f32(x.x, x.y, 0, false); w8 = __builtin_amdgcn_cvt_pk_fp8_f32(x.z, x.w, w8, true);
                const size_t row_ = (size_t)(ptrs[i] - P) / PW;
                if (u < 16) *(int*)(Q8 + row_ * 1024 + u * 64 + 4 * sub) = w8; else *(int*)(K8 + row_ * 256 + (u - 16) * 64 + 4 * sub) = w8;
            }
        }
    }
}

constexpr int AT_WAVE_LDS = 16448 + 512;
__device__ __forceinline__ void attn_main_phase(const bf16_t* P, const unsigned char* Q8, const unsigned char* K8, bf16_t* AO, unsigned char* smem, int wave, int lane_in, int bid, int nblk) {
    float* sc = (float*)(smem + wave * AT_WAVE_LDS);
    unsigned short* idxl = (unsigned short*)(smem + wave * AT_WAVE_LDS + 16448);
    const int b = bid & 7;
    const float NEG_INF = -__builtin_huge_valf();
    const bf16_t* pb = P + (size_t)b * T * PW;
    for (int ug = (bid >> 3); ug < T / 8; ug += (nblk >> 3)) {
        int lane = lane_in; asm volatile("" : "+v"(lane));
        const int n15 = lane & 15, kq = lane >> 4;
        const int t0 = ug * 8, t = t0 + wave;
        const size_t row = (size_t)b * T + t;
        const bf16_t* prow = P + row * PW;
        int nsel;
        if (t0 >= 256) {
            nsel = 256;
            bf16x8 ia[4][2]; float w4[4][4];
#pragma unroll
            for (int mt = 0; mt < 4; ++mt) {
                const bf16_t* qp = pb + (size_t)(t0 + 2 * mt + (n15 >> 3)) * PW + 1536 + (n15 & 7) * 64 + kq * 8;
                ia[mt][0] = *(const bf16x8*)qp; ia[mt][1] = *(const bf16x8*)(qp + 32);
                const u32x2 wr = *(const u32x2*)(pb + (size_t)(t0 + 2 * mt + (kq >> 1)) * PW + 2112 + 4 * (kq & 1));
                w4[mt][0] = bf_lo(wr.x); w4[mt][1] = bf_hi(wr.x); w4[mt][2] = bf_lo(wr.y); w4[mt][3] = bf_hi(wr.y);
            }
            const int ntb = ((t0 + 7) >> 4) + 1;
            auto ldk = [&](bf16x8& d0, bf16x8& d1, int kt) { const bf16_t* kb = pb + (size_t)(16 * kt + n15) * PW + 2048 + kq * 8; d0 = *(const bf16x8*)kb; d1 = *(const bf16x8*)(kb + 32); };
            auto cmp = [&](const bf16x8& d0, const bf16x8& d1, int kt) {
#pragma unroll
                for (int mt = 0; mt < 4; ++mt) {
                    f32x4 acc = (f32x4){0.f, 0.f, 0.f, 0.f};
                    acc = __builtin_amdgcn_mfma_f32_16x16x32_bf16(ia[mt][0], d0, acc, 0, 0, 0);
                    acc = __builtin_amdgcn_mfma_f32_16x16x32_bf16(ia[mt][1], d1, acc, 0, 0, 0);
                    float ps = w4[mt][0] * fmaxf(acc[0], 0.f) + w4[mt][1] * fmaxf(acc[1], 0.f) + w4[mt][2] * fmaxf(acc[2], 0.f) + w4[mt][3] * fmaxf(acc[3], 0.f);
                    ps += __shfl_xor(ps, 16);
                    if ((kq & 1) == 0) ((float*)(smem + (2 * mt + (kq >> 1)) * AT_WAVE_LDS))[16 * kt + n15] = ps;
                }
            };
            bf16x8 xa0, xa1, xb0, xb1, xc0, xc1, xd0, xd1;
            int kt = wave;
            if (kt < ntb) ldk(xa0, xa1, kt);
            if (kt + 8 < ntb) ldk(xb0, xb1, kt + 8);
            if (kt + 16 < ntb) ldk(xc0, xc1, kt + 16);
            for (; kt < ntb; kt += 32) {
                if (kt + 24 < ntb) ldk(xd0, xd1, kt + 24);
                cmp(xa0, xa1, kt);
                if (kt + 32 < ntb) ldk(xa0, xa1, kt + 32);
                if (kt + 8 < ntb) cmp(xb0, xb1, kt + 8);
                if (kt + 40 < ntb) ldk(xb0, xb1, kt + 40);
                if (kt + 16 < ntb) cmp(xc0, xc1, kt + 16);
                if (kt + 48 < ntb) ldk(xc0, xc1, kt + 48);
                if (kt + 24 < ntb) cmp(xd0, xd1, kt + 24);
            }
            __syncthreads();
            unsigned key[65];
#pragma unroll
            for (int r = 0; r < 65; ++r) {
                const int e = r * 64 + lane;
                unsigned uu = __float_as_uint(sc[e]);
                if (uu == 0x80000000u) uu = 0u;
                uu = (uu & 0x80000000u) ? ~uu : (uu | 0x80000000u);
                key[r] = (e <= t) ? uu : 0u;
            }
            unsigned Tk = 0u;
            for (int bit = 31; bit >= 16; --bit) {
                const unsigned cand = Tk | (1u << bit);
                int cnt = 0;
#pragma unroll
                for (int gi = 0; gi < 5; ++gi) {
                    if (gi * 832 <= t) {
#pragma unroll
                        for (int rr = 0; rr < 13; ++rr) cnt += __popcll(__ballot(key[gi * 13 + rr] >= cand));
                    }
                }
                if (cnt >= 256) Tk = cand;
            }
            {
                const unsigned up = Tk + 0x10000u, hsel = Tk >> 16;
                int c_hi = 0, nc = 0;
                unsigned* cl = (unsigned*)sc;
                lds_wave_sync();
#pragma unroll
                for (int r = 0; r < 65; ++r) {
                    const bool hi = (up != 0u) && (key[r] >= up), cd = (key[r] >> 16) == hsel;
                    c_hi += __popcll(__ballot(hi));
                    const unsigned long long mc = __ballot(cd);
                    const int pos = nc + (int)__builtin_amdgcn_mbcnt_hi((unsigned)(mc >> 32), __builtin_amdgcn_mbcnt_lo((unsigned)mc, 0u));
                    if (cd) cl[pos] = key[r] & 0xffffu;
                    nc += __popcll(mc);
                }
                lds_wave_sync();
                const int nch = (nc + 63) >> 6;
                unsigned L = 0u;
                for (int bit = 15; bit >= 0; --bit) {
                    const unsigned cand = L | (1u << bit);
                    int cnt = c_hi;
                    for (int i = 0; i < nch; ++i) { const int ix = i * 64 + lane; const unsigned v = cl[ix]; cnt += __popcll(__ballot((ix < nc) && (v >= cand))); }
                    if (cnt >= 256) L = cand;
                }
                Tk |= L;
            }
            int ngt = 0;
#pragma unroll
            for (int r = 0; r < 65; ++r) ngt += __popcll(__ballot(key[r] > Tk));
            const int need = 256 - ngt;
            lds_wave_sync();
            int pg = 0, pe = 0;
#pragma unroll
            for (int r = 0; r < 65; ++r) {
                const int e = r * 64 + lane;
                const bool gt = key[r] > Tk, eq = key[r] == Tk;
                const unsigned long long mg = __ballot(gt), me = __ballot(eq);
                const int og = pg + (int)__builtin_amdgcn_mbcnt_hi((unsigned)(mg >> 32), __builtin_amdgcn_mbcnt_lo((unsigned)mg, 0u));
                const int oe = pe + (int)__builtin_amdgcn_mbcnt_hi((unsigned)(me >> 32), __builtin_amdgcn_mbcnt_lo((unsigned)me, 0u));
                if (gt) idxl[og] = (unsigned short)e;
                if (eq && oe < need) idxl[ngt + oe] = (unsigned short)e;
                pg += __popcll(mg); pe += __popcll(me);
            }
        } else {
            nsel = t + 1;
#pragma unroll
            for (int j = 0; j < 4; ++j) { const int e = j * 64 + lane; idxl[e] = (unsigned short)(e < t ? e : t); }
        }
        lds_wave_sync();
        const int ntile = (nsel + 15) >> 4;
        typedef long l2_ __attribute__((ext_vector_type(2)));
        const l2_ qv = *(const l2_*)(Q8 + row * 1024 + n15 * 64 + kq * 16);
        const unsigned char* pk8 = K8 + (size_t)b * T * 256;
        f32x4 mx4 = (f32x4){NEG_INF, NEG_INF, NEG_INF, NEG_INF};
        {
            auto ldt = [&](l2_ (&d)[4], int kt) {
                const int krow = idxl[16 * kt + n15];
                const unsigned char* kb = pk8 + (size_t)krow * 256 + kq * 16;
#pragma unroll
                for (int g = 0; g < 4; ++g) d[g] = *(const l2_*)(kb + 64 * g);
            };
            auto cmt = [&](const l2_ (&d)[4], int kt) {
                const int j = 16 * kt + n15;
                f32x4 a0 = (f32x4){0.f, 0.f, 0.f, 0.f}, a1 = a0, a2 = a0, a3 = a0;
                a0 = __builtin_amdgcn_mfma_f32_16x16x32_fp8_fp8(qv.x, d[0].x, a0, 0, 0, 0); a0 = __builtin_amdgcn_mfma_f32_16x16x32_fp8_fp8(qv.y, d[0].y, a0, 0, 0, 0);
                a1 = __builtin_amdgcn_mfma_f32_16x16x32_fp8_fp8(qv.x, d[1].x, a1, 0, 0, 0); a1 = __builtin_amdgcn_mfma_f32_16x16x32_fp8_fp8(qv.y, d[1].y, a1, 0, 0, 0);
                a2 = __builtin_amdgcn_mfma_f32_16x16x32_fp8_fp8(qv.x, d[2].x, a2, 0, 0, 0); a2 = __builtin_amdgcn_mfma_f32_16x16x32_fp8_fp8(qv.y, d[2].y, a2, 0, 0, 0);
                a3 = __builtin_amdgcn_mfma_f32_16x16x32_fp8_fp8(qv.x, d[3].x, a3, 0, 0, 0); a3 = __builtin_amdgcn_mfma_f32_16x16x32_fp8_fp8(qv.y, d[3].y, a3, 0, 0, 0);
                f32x4 sel = (kq == 0) ? a0 : ((kq == 1) ? a1 : ((kq == 2) ? a2 : a3));
#pragma unroll
                for (int r = 0; r < 4; ++r) { sel[r] = (j < nsel) ? sel[r] * 0.125f : NEG_INF; mx4[r] = fmaxf(mx4[r], sel[r]); }
                *(f32x4*)(sc + j * 16 + 4 * kq) = sel;
            };
            l2_ ka[4], kb2[4], kc[4];
            ldt(ka, 0);
            if (1 < ntile) ldt(kb2, 1);
            for (int kt = 0; kt < ntile; kt += 3) {
                if (kt + 2 < ntile) ldt(kc, kt + 2);
                cmt(ka, kt);
                if (kt + 1 < ntile) { if (kt + 3 < ntile) ldt(ka, kt + 3); cmt(kb2, kt + 1); }
                if (kt + 2 < ntile) { if (kt + 4 < ntile) ldt(kb2, kt + 4); cmt(kc, kt + 2); }
            }
        }
#pragma unroll
        for (int r = 0; r < 4; ++r) mx4[r] = row16_max(mx4[r]);
        f32x4 sm4 = (f32x4){0.f, 0.f, 0.f, 0.f};
        for (int kt = 0; kt < ntile; ++kt) {
            float* pp = sc + (16 * kt + n15) * 16 + 4 * kq;
            f32x4 v = *(const f32x4*)pp;
#pragma unroll
            for (int r = 0; r < 4; ++r) { v[r] = __expf(v[r] - mx4[r]); sm4[r] += v[r]; }
            *(f32x4*)pp = v;
        }
#pragma unroll
        for (int r = 0; r < 4; ++r) sm4[r] = 1.0f / row16_sum(sm4[r]);
        float* invl = sc + 4096;
        if (n15 == 0) *(f32x4*)(invl + 4 * kq) = sm4;
        lds_wave_sync();
        const int kp = lane >> 5, pg = (lane >> 3) & 3, d8 = lane & 7;
        float o[4][8];
#pragma unroll
        for (int hh = 0; hh < 4; ++hh)
#pragma unroll
            for (int e = 0; e < 8; ++e) o[hh][e] = 0.f;
        {
            auto ldv = [&](u32x4 (&d)[4], int jp0) {
#pragma unroll
                for (int i = 0; i < 4; ++i) {
                    const int krow = idxl[2 * (jp0 + i) + kp];
                    d[i] = *(const u32x4*)(pb + (size_t)krow * PW + 1280 + pg * 64 + d8 * 8);
                }
            };
            auto cmv = [&](const u32x4 (&d)[4], int jp0) {
#pragma unroll
                for (int i = 0; i < 4; ++i) {
                    const int j = 2 * (jp0 + i) + kp;
                    const f32x4 p4 = *(const f32x4*)(sc + j * 16 + 4 * pg);
                    const float v[8] = {bf_lo(d[i].x), bf_hi(d[i].x), bf_lo(d[i].y), bf_hi(d[i].y), bf_lo(d[i].z), bf_hi(d[i].z), bf_lo(d[i].w), bf_hi(d[i].w)};
#pragma unroll
                    for (int hh = 0; hh < 4; ++hh)
#pragma unroll
                        for (int e = 0; e < 8; ++e) o[hh][e] += p4[hh] * v[e];
                }
            };
            u32x4 va[4], vb2[4];
            const int npairs = 8 * ntile;
            ldv(va, 0);
            for (int c0 = 0; c0 < npairs; c0 += 8) {
                ldv(vb2, c0 + 4);
                cmv(va, c0);
                if (c0 + 8 < npairs) ldv(va, c0 + 8);
                cmv(vb2, c0 + 4);
            }
        }
        {
            const f32x4 iv = *(const f32x4*)(invl + 4 * pg);
#pragma unroll
            for (int hh = 0; hh < 4; ++hh) {
                float r[8];
#pragma unroll
                for (int e = 0; e < 8; ++e) r[e] = (o[hh][e] + __shfl_xor(o[hh][e], 32)) * iv[hh];
                if (lane < 32) *(u32x4*)(AO + row * D + (4 * pg + hh) * 64 + 8 * d8) = (u32x4){pk2(r[0], r[1]), pk2(r[2], r[3]), pk2(r[4], r[5]), pk2(r[6], r[7])};
            }
        }
        __syncthreads();
    }
}

__device__ __forceinline__ void tail_reduce(float* H, const float* PART, int ns, int gtid, int ngt) {
    for (int i = gtid; i < (M - MMAIN) * D / 4; i += ngt) {
        f32x4 v = *(const f32x4*)(H + (size_t)MMAIN * D + (size_t)i * 4);
        for (int s = 0; s < ns; ++s) v = v + *(const f32x4*)(PART + (size_t)s * ((size_t)(M - MMAIN) * D) + (size_t)i * 4);
        *(f32x4*)(H + (size_t)MMAIN * D + (size_t)i * 4) = v;
    }
}

struct Ctx { int tid, lane, wave, gw, ngw, bid, nblk; };
__device__ __forceinline__ Ctx mkctx() {
    int tid = threadIdx.x, bid = blockIdx.x, nb = gridDim.x;
    asm volatile("" : "+v"(tid)); asm volatile("" : "+s"(bid)); asm volatile("" : "+s"(nb));
    Ctx c; c.tid = tid; c.lane = tid & 63; c.wave = __builtin_amdgcn_readfirstlane(tid >> 6); c.bid = bid; c.nblk = nb; c.gw = bid * 8 + c.wave; c.ngw = nb * 8; return c;
}
template <class T_> __device__ __forceinline__ T_* launder(T_* ptr) { return ptr; }

#ifdef DUP_SYNC
#define EXTRA_SYNC() grid.sync()
#else
#define EXTRA_SYNC()
#endif
#define PHASE_END() do { if (phase == 0) grid.sync(); else xcd_barrier(xb); EXTRA_SYNC(); ++phase; if (STOP_AFTER == phase) { dump_h(p, H); return; } } while (0)
__device__ __forceinline__ void dump_h(const Params& p, const float* H) {
    for (size_t i = (size_t)blockIdx.x * 512 + threadIdx.x; i < (size_t)NB * SEQ * D / 4; i += (size_t)gridDim.x * 512) {
        const size_t e = i * 4, orow = e / D, c = e % D, b_ = orow / SEQ, t_ = orow % SEQ; *(f32x4*)(p.out + e) = *(const f32x4*)(H + ((size_t)b_ * T + t_ + NMETA) * D + c); }
}

__global__ void __launch_bounds__(512, 2) fwd_mega(Params p) {
    extern __shared__ __attribute__((aligned(16))) unsigned char smem[];
    cg::grid_group grid = cg::this_grid();
    int phase = 0;
    volatile LAS unsigned* xst = (volatile LAS unsigned*)(smem + LDS_BYTES - 16);
    if (threadIdx.x == 0) { xst[0] = 0u; xst[1] = 0u; }
    __syncthreads();
    XcdBarrier xb = xcd_barrier_post((unsigned*)(p.ws + OFF_BAR), xst);
#define WS_ (launder(p.ws))
#define H_ ((float*)(WS_ + OFF_H))
#define WB_ (WS_ + OFF_WB)
    float* H = (float*)(p.ws + OFF_H);

#define FFN_BLOCK(LAYER, SUB, FI, NSPREV) do { \
        const float* ng = p.in[2] + (size_t)(LAYER) * 3 * D + (SUB) * D; \
        for (int rep_ = 0; rep_ < NREP_NORM; ++rep_) { Ctx c = mkctx(); float* scr = (float*)(smem + c.wave * 8448); int trot = 0; \
          const float* w_in = p.in[3] + ((size_t)(LAYER) * 2 + (FI)) * (size_t)D * 2 * FF; \
          const float* w_out = p.in[4] + ((size_t)(LAYER) * 2 + (FI)) * (size_t)FF * D; \
          tr_job(w_in, D, 2 * FF, 2 * FF, nullptr, 1, (bf16_t*)(WB_ + WB_W1T), D, 0, 0, 2 * FF, D, scr, c.gw, c.ngw, c.lane, trot); \
          tr_job(w_out, FF, D, D, nullptr, 0, (bf16_t*)(WB_ + WB_W2T), LDF, 0, 0, D, FF, scr, c.gw, c.ngw, c.lane, trot); \
          if ((LAYER) == 0 && (SUB) == 0) norm_phase<1>(p, ng, H_, (bf16_t*)(WS_ + OFF_XN), c.gw, c.ngw, c.lane); \
          else norm_phase<0>(p, ng, H_, (bf16_t*)(WS_ + OFF_XN), c.gw, c.ngw, c.lane, (const float*)(WS_ + OFF_PART), NSPREV); } \
        PHASE_END(); \
        { EpiSwiGLU E; E.O = (bf16_t*)(WS_ + OFF_ACT); run_gemm(smem, (const bf16_t*)(WS_ + OFF_XN), (const bf16_t*)(WB_ + WB_W1T), 2 * FF, D, E, 0); } \
        PHASE_END(); \
        { EpiResid<((LAYER) == 1 && (SUB) == 2)> E; E.H = H_; E.scale = 0.5f; E.out = p.out; run_gemm(smem, (const bf16_t*)(WS_ + OFF_ACT), (const bf16_t*)(WB_ + WB_W2T), D, FF, E, 0, MMAIN, LDF); } \
        run_gemm_tail(smem, (const bf16_t*)(WS_ + OFF_ACT), (const bf16_t*)(WB_ + WB_W2T), FF, (float*)(WS_ + OFF_PART), 0.5f, 100, LDF); \
        PHASE_END(); } while (0)

    FFN_BLOCK(0, 0, 0, 0);
#ifndef NO_RWKV
    {
        bf16_t* Y = (bf16_t*)p.out; bf16_t* L1 = (bf16_t*)((unsigned char*)p.out + SZ_B16);
        { Ctx c = mkctx(); tail_reduce(H_, (const float*)(WS_ + OFF_PART), 11, c.bid * 512 + c.tid, c.nblk * 512); }
        xcd_barrier(xb);
        for (int rep_ = 0; rep_ < NREP_NORM; ++rep_) {
            Ctx c = mkctx(); float* scr = (float*)(smem + c.wave * 8448); int trot = 0;
            bf16_t* WPT = (bf16_t*)(WB_ + WB_WPT); bf16_t* L2W = (bf16_t*)(WB_ + WB_L2W); bf16_t* WOT = (bf16_t*)(WB_ + WB_RWO);
            const float* mix = p.in[5];
            tr_job(p.in[6], D, D, D, nullptr, 0, WPT, 2 * D, 0, 0, D, D, scr, c.gw, c.ngw, c.lane, trot);
            tr_job(p.in[6], D, D, D, mix + 0 * D, 0, WPT, 2 * D, 0, D, D, D, scr, c.gw, c.ngw, c.lane, trot);
            tr_job(p.in[7], D, D, D, nullptr, 0, WPT, 2 * D, 1024, 0, D, D, scr, c.gw, c.ngw, c.lane, trot);
            tr_job(p.in[7], D, D, D, mix + 2 * D, 0, WPT, 2 * D, 1024, D, D, D, scr, c.gw, c.ngw, c.lane, trot);
            tr_job(p.in[8], D, D, D, nullptr, 0, WPT, 2 * D, 2048, 0, D, D, scr, c.gw, c.ngw, c.lane, trot);
            tr_job(p.in[8], D, D, D, mix + 3 * D, 0, WPT, 2 * D, 2048, D, D, D, scr, c.gw, c.ngw, c.lane, trot);
            tr_job(p.in[11], D, 64, 64, nullptr, 0, WPT, 2 * D, 3072, 0, 256, D, scr, c.gw, c.ngw, c.lane, trot);
            tr_job(p.in[11], D, 64, 64, mix + 1 * D, 0, WPT, 2 * D, 3072, D, 256, D, scr, c.gw, c.ngw, c.lane, trot);
            tr_job(p.in[14], D, 64, 64, nullptr, 0, WPT, 2 * D, 3328, 0, 256, D, scr, c.gw, c.ngw, c.lane, trot);
            tr_job(p.in[14], D, 64, 64, mix + 4 * D, 0, WPT, 2 * D, 3328, D, 256, D, scr, c.gw, c.ngw, c.lane, trot);
            tr_job(p.in[16], D, 160, 160, nullptr, 0, WPT, 2 * D, 3584, 0, 256, D, scr, c.gw, c.ngw, c.lane, trot);
            tr_job(p.in[16], D, 160, 160, mix + 5 * D, 0, WPT, 2 * D, 3584, D, 256, D, scr, c.gw, c.ngw, c.lane, trot);
            tr_job(p.in[12], 64, D, D, nullptr, 0, L2W, 256, 0, 0, D, 256, scr, c.gw, c.ngw, c.lane, trot);
            tr_job(p.in[15], 64, D, D, nullptr, 0, L2W + (size_t)1024 * 256, 256, 0, 0, D, 256, scr, c.gw, c.ngw, c.lane, trot);
            tr_job(p.in[17], 160, D, D, nullptr, 0, L2W + (size_t)2 * 1024 * 256, 256, 0, 0, D, 256, scr, c.gw, c.ngw, c.lane, trot);
            tr_job(p.in[9], D, D, D, nullptr, 0, WOT, D, 0, 0, D, D, scr, c.gw, c.ngw, c.lane, trot);
            norm_phase<2>(p, p.in[2] + D, H_, (bf16_t*)(WS_ + OFF_AP), c.gw, c.ngw, c.lane);
        }
        PHASE_END();
#ifndef NO_G1
        { EpiBf<1> E; E.O0 = (bf16_t*)(WS_ + OFF_RKV); E.O1 = L1; E.bias = nullptr; E.ldo = D; run_gemm(smem, (const bf16_t*)(WS_ + OFF_AP), (const bf16_t*)(WB_ + WB_WPT), 3840, 2 * D, E, 0); }
#endif
        PHASE_END();
#ifndef NO_G23
        { EpiBf<0> E; E.O0 = (bf16_t*)(WS_ + OFF_E); E.O1 = nullptr; E.bias = nullptr; E.ldo = D; run_gemm(smem, L1, (const bf16_t*)(WB_ + WB_L2W), D, 256, E, 0); }
        { EpiBf<0> E; E.O0 = (bf16_t*)(WS_ + OFF_ASIG); E.O1 = nullptr; E.bias = nullptr; E.ldo = D; run_gemm(smem, L1 + (size_t)MP * 256, (const bf16_t*)(WB_ + WB_L2W) + (size_t)1024 * 256, D, 256, E, 64); }
#endif
        PHASE_END();
#ifndef NO_SCAN
        scan_phase(p, WS_, Y, smem);
#ifdef DUP_SCAN
        grid.sync(); scan_phase(p, WS_, Y, smem);
#endif
#endif
        PHASE_END();
        { EpiBf<0> E; E.O0 = (bf16_t*)(WS_ + OFF_E); E.O1 = nullptr; E.bias = nullptr; E.ldo = D; run_gemm(smem, L1 + (size_t)2 * MP * 256, (const bf16_t*)(WB_ + WB_L2W) + (size_t)2 * 1024 * 256, D, 256, E, 128); }
        PHASE_END();
#ifndef NO_RPOST
        { Ctx c = mkctx(); rwkv_post_phase(p, WS_, Y, c.gw, c.ngw, c.lane); }
#endif
        PHASE_END();
        { EpiResid<false> E; E.H = H_; E.scale = 1.0f; E.out = nullptr; run_gemm(smem, Y, (const bf16_t*)(WB_ + WB_RWO), D, D, E, 0, MMAIN); }
        run_gemm_tail(smem, Y, (const bf16_t*)(WB_ + WB_RWO), D, (float*)(WS_ + OFF_PART), 1.0f, 100);
        PHASE_END();
    }
#endif
    FFN_BLOCK(0, 2, 1, 4);
    FFN_BLOCK(1, 0, 0, 11);
#ifndef NO_ATTN
    {
        for (int rep_ = 0; rep_ < NREP_NORM; ++rep_) {
            Ctx c = mkctx(); float* scr = (float*)(smem + c.wave * 8448); int trot = 0;
            tr_job(p.in[23], D, 2120, 2120, nullptr, 0, (bf16_t*)(WB_ + WB_WIT), D, 0, 0, PW, D, scr, c.gw, c.ngw, c.lane, trot);
            tr_job(p.in[26], D, D, D, nullptr, 0, (bf16_t*)(WB_ + WB_AWO), D, 0, 0, D, D, scr, c.gw, c.ngw, c.lane, trot);
            rope_table_phase(p, (float*)(WS_ + OFF_TAB), c.bid * 512 + c.tid, c.nblk * 512);
            norm_phase<0>(p, p.in[2] + 3 * D + D, H_, (bf16_t*)(WS_ + OFF_HN), c.gw, c.ngw, c.lane, (const float*)(WS_ + OFF_PART), 11);
        }
        PHASE_END();
        { EpiBf<0> E; E.O0 = (bf16_t*)(WS_ + OFF_P); E.O1 = nullptr; E.bias = nullptr; E.ldo = PW; run_gemm(smem, (const bf16_t*)(WS_ + OFF_HN), (const bf16_t*)(WB_ + WB_WIT), PW, D, E, 0); }
        PHASE_END();
#ifndef NO_APOST
        { Ctx c = mkctx(); attn_post_phase(p, (bf16_t*)(WS_ + OFF_P), (const float*)(WS_ + OFF_TAB), WS_ + OFF_Q8, WS_ + OFF_K8, c.gw, c.ngw, c.lane); }
#endif
        PHASE_END();
#ifndef NO_AMAIN
        { Ctx c = mkctx(); attn_main_phase((const bf16_t*)(WS_ + OFF_P), WS_ + OFF_Q8, WS_ + OFF_K8, (bf16_t*)(WS_ + OFF_HN), smem, c.wave, c.lane, c.bid, c.nblk); }
#ifdef DUP_AMAIN
        grid.sync(); { Ctx c = mkctx(); attn_main_phase((const bf16_t*)(WS_ + OFF_P), WS_ + OFF_Q8, WS_ + OFF_K8, (bf16_t*)(WS_ + OFF_HN), smem, c.wave, c.lane, c.bid, c.nblk); }
#endif
#endif
        PHASE_END();
        { EpiResid<false> E; E.H = H_; E.scale = 1.0f; E.out = nullptr; run_gemm(smem, (const bf16_t*)(WS_ + OFF_HN), (const bf16_t*)(WB_ + WB_AWO), D, D, E, 0, MMAIN); }
        run_gemm_tail(smem, (const bf16_t*)(WS_ + OFF_HN), (const bf16_t*)(WB_ + WB_AWO), D, (float*)(WS_ + OFF_PART), 1.0f, 100);
        PHASE_END();
    }
#endif
    FFN_BLOCK(1, 2, 1, 4);
    for (int i = blockIdx.x * 512 + threadIdx.x; i < (M - MMAIN) * D / 4; i += gridDim.x * 512) {
        const int row = MMAIN + (i * 4) / D, c = (i * 4) % D, b_ = row / T, t_ = row - b_ * T;
        f32x4 v = *(const f32x4*)(H + (size_t)row * D + c);
        const float* PART = (const float*)(p.ws + OFF_PART);
        for (int s = 0; s < 11; ++s) v = v + *(const f32x4*)(PART + ((size_t)s * (M - MMAIN) + (row - MMAIN)) * D + c);
        *(f32x4*)(p.out + ((size_t)b_ * SEQ + (t_ - NMETA)) * D + c) = v;
    }
}

extern "C" void kernel_launch(void* const* d_in, const int* in_sizes, int n_in, void* d_out, int out_size, void* d_ws, size_t ws_size, hipStream_t stream) {
    static int grid_blocks = 0;
    if (!grid_blocks) {
        int dev = 0, cus = 0, per_cu = 0;
        (void)hipGetDevice(&dev);
        (void)hipDeviceGetAttribute(&cus, hipDeviceAttributeMultiprocessorCount, dev);
        if (hipFuncSetAttribute((const void*)fwd_mega, hipFuncAttributeMaxDynamicSharedMemorySize, LDS_BYTES) != hipSuccess) fprintf(stderr, "hipFuncSetAttribute failed\n");
        if (hipOccupancyMaxActiveBlocksPerMultiprocessor(&per_cu, (const void*)fwd_mega, 512, LDS_BYTES) != hipSuccess || per_cu < 1) { fprintf(stderr, "occupancy query: %d\n", per_cu); per_cu = 1; }
        (void)hipGetLastError();
        grid_blocks = cus;
        if (grid_blocks % 8) grid_blocks -= grid_blocks % 8;
        if (ws_size < ((size_t)512 << 20)) fprintf(stderr, "workspace too small: %zu\n", ws_size);
    }
    Params p{};
    for (int i = 0; i < 27; ++i) p.in[i] = (const float*)d_in[i];
    p.out = (float*)d_out; p.ws = (unsigned char*)d_ws;
    for (int i = 0; i < 8; ++i) p.inv[i] = (float)pow(500000.0, -(double)i / 8.0);
    (void)hipMemsetAsync((unsigned char*)d_ws + OFF_BAR, 0, XCD_BAR_WORDS * sizeof(unsigned), stream);
    void* args[] = {&p};
    hipError_t e = hipLaunchCooperativeKernel((const void*)fwd_mega, dim3(grid_blocks), dim3(512), args, LDS_BYTES, stream);
    if (e != hipSuccess) fprintf(stderr, "cooperative launch failed: %s (grid %d)\n", hipGetErrorString(e), grid_blocks);
}
```

```cpp
#include <hip/hip_runtime.h>
#include <hip/hip_cooperative_groups.h>
#include <cstdio>
namespace cg = cooperative_groups;
namespace pg8 {
#define PG8_LAS __attribute__((address_space(3)))
typedef unsigned short bf16_t;
typedef short bf16x8 __attribute__((ext_vector_type(8)));
typedef float f32x4 __attribute__((ext_vector_type(4)));
typedef unsigned u32x4 __attribute__((ext_vector_type(4)));
constexpr int BM = 256, BK = 64, HALF = 128, HTB = HALF * BK * 2  , STAGE_BYTES = 8 * HTB, NXCD = 8, WGM = 8;

__host__ __device__ __forceinline__ int lds_byte(int r, int c) { const int st = (r >> 4) * 2 + (c >> 5), rr = r & 15, cc = c & 31, ob = rr * 64 + cc * 2; return st * 1024 + (ob ^ (((ob >> 9) & 1) << 5)); }
__host__ __device__ __forceinline__ void stage_rc(int b, int& R, int& C) { const int st = b / 1024, sb = b % 1024, swz = sb ^ (((sb >> 9) & 1) << 5); R = (st >> 1) * 16 + swz / 64; C = (st & 1) * 32 + (swz % 64) / 2; }
__host__ __device__ __forceinline__ int perm32(int rho) { const int n = rho >> 4, i = rho & 15; return 8 * (i >> 2) + 4 * n + (i & 3); }

struct Unit { int pm, pn; };
struct Gemm { const bf16_t* A; const bf16_t* Bt; int M, N, K, ld; };

struct StaticOrder {
    int nM, nN, nwg, G, c;
    __host__ __device__ void init(int M, int N, int G_, int c_) { nM = M / BM; nN = N / BM; nwg = nM * nN; G = G_; c = c_; }
    __host__ __device__ bool next(int i, Unit& u) const {
        const long L = (long)i * G + c; if (L >= nwg) return false;
        int wgid = (int)L; { const int q = nwg / NXCD, r = nwg % NXCD, xcd = wgid % NXCD, off = wgid / NXCD; wgid = (xcd < r ? xcd * (q + 1) : r * (q + 1) + (xcd - r) * q) + off; }
        const int nig = WGM * nN, gid = wgid / nig, fm = gid * WGM, gsz = (nM - fm) < WGM ? (nM - fm) : WGM;
        u.pm = fm + ((wgid % nig) % gsz); u.pn = (wgid % nig) / gsz; return true;
    }
    __device__ __forceinline__ void a_ready(const Unit&) const {}
    __device__ __forceinline__ void done(const Unit&) const {}
    __device__ __forceinline__ size_t aoff(const Unit& u, size_t tstep) const { return (size_t)u.pm * tstep; }
    __device__ __forceinline__ size_t boff(const Unit& u, size_t tstep) const { return (size_t)u.pn * tstep; }
};
struct SplitKOrder {
    int ncol, nun, G, c;
    __device__ void init(int ncol_, int nslice, int G_, int c_) { ncol = ncol_; nun = ncol_ * nslice; G = G_; c = c_; }
    __device__ bool next(int i, Unit& u) const { const long L = (long)i * G + c; if (L >= nun) return false; u.pm = 0; u.pn = (int)L; return true; }
    __device__ __forceinline__ void a_ready(const Unit&) const {}
    __device__ __forceinline__ void done(const Unit&) const {}
    __device__ __forceinline__ size_t aoff(const Unit& u, size_t) const { return (size_t)(u.pn / ncol) * 512; }
    __device__ __forceinline__ size_t boff(const Unit& u, size_t tstep) const { return (size_t)(u.pn % ncol) * tstep + (size_t)(u.pn / ncol) * 512; }
};
__device__ __forceinline__ unsigned cvt_pk_bf16(float lo, float hi) { unsigned r; asm volatile("v_cvt_pk_bf16_f32 %0, %1, %2" : "=v"(r) : "v"(lo), "v"(hi)); return r; }

template <class Epi, class Sched, bool STAMP = false>
__device__ __forceinline__ void gemm_phase(PG8_LAS unsigned char* lds, const Gemm g, const Sched& S, const Epi& E, unsigned long long* stamps) {
    int tid_l = threadIdx.x; asm volatile("" : "+v"(tid_l));
    const int tid = tid_l, wid = __builtin_amdgcn_readfirstlane(tid >> 6), lane = tid & 63, wr = wid >> 2, wc = wid & 3, fr = lane & 15, fq = lane >> 4;
    const int K = g.K, nt = K / BK;
    int ts_lo = 0, ts_hi = 0, nts = 0; const unsigned long long rt_entry = STAMP ? (unsigned long long)wall_clock64() : 0ull;
#define PG8_STAMP() do { if (STAMP && wid == 0 && nts < 64) { const unsigned long long _c = (unsigned long long)clock64(); \
        ts_lo = (lane == nts) ? (int)(unsigned)_c : ts_lo; ts_hi = (lane == nts) ? (int)(unsigned)(_c >> 32) : ts_hi; ++nts; } } while (0)
    PG8_STAMP();
    unsigned voffA[2], voffB[2];
#pragma unroll
    for (int i = 0; i < 2; ++i) { int R, C; stage_rc(tid * 16 + i * 8192, R, C); const int Rb = Epi::PERM ? ((R & ~31) + perm32(R & 31)) : R;
        voffA[i] = (unsigned)(R * g.ld + C) * 2u; voffB[i] = (unsigned)(Rb * g.ld + C) * 2u; }
    const size_t kstep = (size_t)(BK * 2);
    const size_t hstep = (size_t)HALF * g.ld * 2;
    const size_t tstep = 2 * hstep;
    const unsigned ldsw = (unsigned)wid * 1024u;
    const int aoff = lds_byte(wr * 64 + fr, fq * 8), boff = lds_byte(wc * 32 + fr, fq * 8);
#define PG8_SA(b, h) (((b) * 2 + (h)) * HTB)
#define PG8_SB(b, h) ((4 + (b) * 2 + (h)) * HTB)
#define PG8_STAGE(bufoff, gbase, voff) do { _Pragma("unroll") for (int _i = 0; _i < 2; ++_i) \
        __builtin_amdgcn_global_load_lds((const unsigned*)((const char*)(gbase) + (voff)[_i]), (PG8_LAS unsigned*)(lds + (bufoff) + ldsw + _i * 8192), 16, 0, 0); } while (0)
#define PG8_LDA(dst, b, h) do { _Pragma("unroll") for (int m = 0; m < 4; ++m) _Pragma("unroll") for (int k = 0; k < 2; ++k) dst[m][k] = *(const PG8_LAS bf16x8*)(lds + PG8_SA(b, h) + aoff + m * 2048 + k * 1024); } while (0)
#define PG8_LDB(dst, b, h) do { _Pragma("unroll") for (int n = 0; n < 2; ++n) _Pragma("unroll") for (int k = 0; k < 2; ++k) dst[n][k] = *(const PG8_LAS bf16x8*)(lds + PG8_SB(b, h) + boff + n * 2048 + k * 1024); } while (0)
#define PG8_MMA(ai, bj, At, Bt) do { __builtin_amdgcn_s_setprio(1); _Pragma("unroll") for (int m = 0; m < 4; ++m) _Pragma("unroll") for (int n = 0; n < 2; ++n) _Pragma("unroll") for (int k = 0; k < 2; ++k) \
        acc[ai][bj][m][n] = __builtin_amdgcn_mfma_f32_16x16x32_bf16(Bt[n][k], At[m][k], acc[ai][bj][m][n], 0, 0, 0); __builtin_amdgcn_s_setprio(0); } while (0)
#define PG8_WAIT_V(n) asm volatile("s_waitcnt vmcnt(" #n ")" ::: "memory")
#define PG8_WAIT_L(n) asm volatile("s_waitcnt lgkmcnt(" #n ")" ::: "memory")
#define PG8_BAR __builtin_amdgcn_s_barrier()
#define PG8_SCHED __builtin_amdgcn_sched_barrier(0)
    Unit cur, nxt; int ui = 0;
    if (!S.next(0, cur)) return;
    f32x4 acc[2][2][4][2];
#pragma unroll
    for (int a = 0; a < 2; ++a)
#pragma unroll
        for (int b = 0; b < 2; ++b)
#pragma unroll
            for (int m = 0; m < 4; ++m)
#pragma unroll
                for (int n = 0; n < 2; ++n) acc[a][b][m][n] = (f32x4){0.f, 0.f, 0.f, 0.f};
    bf16x8 At[4][2], B0[2][2], B1[2][2];
    const char* cA = (const char*)g.A + S.aoff(cur, tstep); const char* cB = (const char*)g.Bt + S.boff(cur, tstep);
    S.a_ready(cur);
    PG8_STAGE(PG8_SB(0, 0), cB, voffB); PG8_STAGE(PG8_SA(0, 0), cA, voffA); PG8_STAGE(PG8_SB(0, 1), cB + hstep, voffB); PG8_STAGE(PG8_SA(0, 1), cA + hstep, voffA);
    if (wr == 1) PG8_BAR;
    PG8_WAIT_V(4); PG8_BAR;
    PG8_STAGE(PG8_SB(1, 0), cB + kstep, voffB); PG8_STAGE(PG8_SA(1, 0), cA + kstep, voffA); PG8_STAGE(PG8_SB(1, 1), cB + hstep + kstep, voffB);
    PG8_WAIT_V(6); PG8_BAR;
    PG8_STAMP();
    for (;;) {
        const bool has_next = S.next(ui + 1, nxt);
        const char* nA = has_next ? (const char*)g.A + S.aoff(nxt, tstep) : cA; const char* nB = has_next ? (const char*)g.Bt + S.boff(nxt, tstep) : cB;
        for (int t = 0; t < nt; t += 2) {
            const bool last = (t == nt - 2);
            const char* a1 = cA + (size_t)(t + 1) * kstep;
            const char* a2 = last ? nA : cA + (size_t)(t + 2) * kstep; const char* b2 = last ? nB : cB + (size_t)(t + 2) * kstep;
            const char* a3 = a2 + kstep; const char* b3 = b2 + kstep;
            if (last && has_next) S.a_ready(nxt);
            PG8_LDB(B0, 0, 0); PG8_SCHED; PG8_LDA(At, 0, 0); PG8_STAGE(PG8_SA(1, 1), a1 + hstep, voffA);
            PG8_WAIT_L(8); PG8_BAR; PG8_WAIT_L(0); PG8_MMA(0, 0, At, B0); PG8_BAR; PG8_SCHED;
            PG8_LDB(B1, 0, 1); PG8_STAGE(PG8_SB(0, 0), b2, voffB);
            PG8_BAR; PG8_WAIT_L(0); PG8_MMA(0, 1, At, B1); PG8_BAR;
            PG8_LDA(At, 0, 1); PG8_STAGE(PG8_SA(0, 0), a2, voffA);
            PG8_BAR; PG8_WAIT_L(0); PG8_MMA(1, 0, At, B0); PG8_BAR; PG8_SCHED;
            PG8_STAGE(PG8_SB(0, 1), b2 + hstep, voffB);
            PG8_WAIT_V(6); PG8_BAR; PG8_MMA(1, 1, At, B1); PG8_BAR;
            PG8_LDB(B0, 1, 0); PG8_SCHED; PG8_LDA(At, 1, 0); PG8_STAGE(PG8_SA(0, 1), a2 + hstep, voffA);
            PG8_WAIT_L(8); PG8_BAR; PG8_WAIT_L(0); PG8_MMA(0, 0, At, B0); PG8_BAR; PG8_SCHED;
            PG8_LDB(B1, 1, 1); PG8_STAGE(PG8_SB(1, 0), b3, voffB);
            PG8_BAR; PG8_WAIT_L(0); PG8_MMA(0, 1, At, B1); PG8_BAR;
            PG8_LDA(At, 1, 1); PG8_STAGE(PG8_SA(1, 0), a3, voffA);
            PG8_BAR; PG8_WAIT_L(0); PG8_MMA(1, 0, At, B0); PG8_BAR; PG8_SCHED;
            PG8_STAGE(PG8_SB(1, 1), b3 + hstep, voffB);
            PG8_WAIT_V(6); PG8_BAR; PG8_MMA(1, 1, At, B1); PG8_BAR;
        }
        PG8_STAMP();
        if constexpr (!Epi::AFTER_DRAIN) { E(acc, cur, wr, wc, fr, fq); S.done(cur); }
        PG8_STAMP();
        if (!has_next) break;
#pragma unroll
        for (int a = 0; a < 2; ++a)
#pragma unroll
            for (int b = 0; b < 2; ++b)
#pragma unroll
                for (int m = 0; m < 4; ++m)
#pragma unroll
                    for (int n = 0; n < 2; ++n) acc[a][b][m][n] = (f32x4){0.f, 0.f, 0.f, 0.f};
        cur = nxt; cA = nA; cB = nB; ++ui;
    }
    PG8_WAIT_V(0);
    if (wr == 0) PG8_BAR;
    PG8_BAR;
    if constexpr (Epi::AFTER_DRAIN) { E.fused(acc, cur, wr, wc, fr, fq, lds, wid, lane); S.done(cur); }
    PG8_STAMP();
    if (STAMP && wid == 0) { stamps[lane] = lane < nts ? (((unsigned long long)(unsigned)ts_hi << 32) | (unsigned)ts_lo) : 0ull;
        if (lane == 62) stamps[62] = rt_entry; if (lane == 63) stamps[63] = (unsigned long long)wall_clock64(); }
#undef PG8_STAMP
#undef PG8_SA
#undef PG8_SB
#undef PG8_STAGE
#undef PG8_LDA
#undef PG8_LDB
#undef PG8_MMA
#undef PG8_WAIT_V
#undef PG8_WAIT_L
#undef PG8_BAR
#undef PG8_SCHED
}
}
#define XB_TMO      128
#define XB_XCNT(j)  (256  + 64 * (j))
#define XB_XSUB(j)  (1280 + 64 * (j))
#define XB_XGEN(j)  (2304 + 64 * (j))
#define XB_TOP      3328
#define XB_TOPGEN   3392
#define XCD_BAR_WORDS 3456
#define XB_SPIN_CAP (1u << 18)
#ifndef LAS
#define LAS __attribute__((address_space(3)))
#endif

__device__ __forceinline__ unsigned xb_ld(unsigned* p)              { return __hip_atomic_load(p, __ATOMIC_RELAXED, __HIP_MEMORY_SCOPE_AGENT); }
__device__ __forceinline__ unsigned xb_add(unsigned* p, unsigned v) { return __hip_atomic_fetch_add(p, v, __ATOMIC_RELAXED, __HIP_MEMORY_SCOPE_AGENT); }
__device__ __forceinline__ unsigned xb_xcc_id() { return (unsigned)__builtin_amdgcn_s_getreg((3 << 11) | 20) & 0xFu; }
#define XB_SPIN(cond, bar) do { unsigned _sp = 0; while (cond) { __builtin_amdgcn_s_sleep(1); \
    if ((++_sp & 255u) == 0u) { if (xb_ld(&(bar)[XB_TMO])) break; if (_sp > XB_SPIN_CAP) { atomicAdd(&(bar)[XB_TMO], 1u); break; } } } } while (0)

struct XcdBarrier {
    unsigned* bar; unsigned x;
    volatile LAS unsigned* st;
};

__device__ __forceinline__ XcdBarrier xcd_barrier_post(unsigned* bar, volatile LAS unsigned* st) {
    XcdBarrier b; b.bar = bar; b.x = xb_xcc_id(); b.st = st;
    if (threadIdx.x == 0) (void)xb_add(&bar[XB_XCNT(b.x)], 1u);
    return b;
}
__device__ __forceinline__ void xcd_barrier_complete(unsigned* bar, unsigned x, unsigned& nloc, unsigned& nx) {
    const unsigned G = gridDim.x * gridDim.y * gridDim.z;
    unsigned sum, cnt, mine, sp = 0u;
    for (;;) {
        sum = 0u; cnt = 0u; mine = 0u;
#pragma unroll
        for (unsigned j = 0; j < 16; ++j) { const unsigned c = xb_ld(&bar[XB_XCNT(j)]); sum += c; cnt += (c > 0u) ? 1u : 0u; mine = (j == x) ? c : mine; }
        if (sum == G) break;
        __builtin_amdgcn_s_sleep(1);
        if ((++sp & 255u) == 0u) { if (xb_ld(&bar[XB_TMO])) break; if (sp > XB_SPIN_CAP) { atomicAdd(&bar[XB_TMO], 1u); break; } }
    }
    nloc = mine > 0u ? mine : 1u; nx = cnt > 0u ? cnt : 1u;
}

__device__ __forceinline__ void xcd_barrier(const XcdBarrier& b) {
    asm volatile("s_waitcnt vmcnt(0)" ::: "memory");
    __syncthreads();
    if (threadIdx.x == 0) {
        unsigned* bar = b.bar;
        __builtin_amdgcn_s_waitcnt(0);
        unsigned nloc = b.st[0], nx = b.st[1];
        if (nloc == 0u) { xcd_barrier_complete(bar, b.x, nloc, nx); b.st[0] = nloc; b.st[1] = nx; }
        const unsigned old = xb_add(&bar[XB_XSUB(b.x)], 1u);
        const unsigned gen = old / nloc;
        if (old + 1u == (gen + 1u) * nloc) {
            __builtin_amdgcn_fence(__ATOMIC_RELEASE, "agent");
            asm volatile("s_waitcnt vmcnt(0)" ::: "memory");
            const unsigned og = xb_add(&bar[XB_TOP], 1u);
            const unsigned tg = og / nx;
            if (og + 1u == (tg + 1u) * nx) xb_add(&bar[XB_TOPGEN], 1u);
            else XB_SPIN(xb_ld(&bar[XB_TOPGEN]) == tg, bar);
            __builtin_amdgcn_fence(__ATOMIC_ACQUIRE, "agent");
            xb_add(&bar[XB_XGEN(b.x)], 1u);
            asm volatile("s_waitcnt vmcnt(0)" ::: "memory");
        } else {
            XB_SPIN(xb_ld(&bar[XB_XGEN(b.x)]) == gen, bar);
            __builtin_amdgcn_fence(__ATOMIC_ACQUIRE, "agent");
            asm volatile("s_waitcnt vmcnt(0)" ::: "memory");
        }
    }
    __syncthreads();
}


using pg8::bf16_t; using pg8::f32x4; using pg8::u32x4; using pg8::bf16x8;
typedef unsigned u32x2 __attribute__((ext_vector_type(2)));

constexpr int NB = 8, T = 4112, SEQ = 4096, NMETA = 16, D = 1024, FF = 2816;
constexpr int M = NB * T;
constexpr int MP = 33024;
constexpr int MMAIN = 32768;
constexpr int LDS_BYTES = 147456;
constexpr int LDF = 2880;
constexpr int PW = 2304;
#ifndef NREP_NORM
#define NREP_NORM 1
#endif
#ifndef STOP_AFTER
#define STOP_AFTER 99
#endif

struct Params { const float* in[27]; float* out; unsigned char* ws; float inv[8]; };

constexpr size_t SZ_H = (size_t)MP * D * 4, SZ_B16 = (size_t)MP * D * 2;
constexpr size_t OFF_H = 0, OFF_WB = OFF_H + SZ_H, SZ_WB = (size_t)20 << 20, OFF_R = OFF_WB + SZ_WB;
constexpr size_t OFF_XN = OFF_R, OFF_ACT = OFF_R + SZ_B16;
constexpr size_t OFF_AP = OFF_R, OFF_E = OFF_R, OFF_ASIG = OFF_R + SZ_B16, OFF_RKV = OFF_R + 2 * SZ_B16;
constexpr size_t SZ_L1 = (size_t)MP * 256 * 2;
constexpr size_t OFF_BAR = (size_t)500 << 20;
constexpr size_t OFF_PART = (size_t)501 << 20;
constexpr size_t OFF_HN = OFF_R, OFF_P = OFF_R + SZ_B16, OFF_TAB = OFF_P + (size_t)MP * PW * 2;
constexpr size_t OFF_Q8 = OFF_TAB + ((size_t)1 << 20);
constexpr size_t OFF_K8 = OFF_Q8 + (size_t)MP * 1024;
static_assert(OFF_K8 + (size_t)MP * 256 <= OFF_BAR, "ws");
constexpr size_t WB_W1T = 0, WB_W2T = (size_t)5632 * 1024 * 2;
static_assert(WB_W2T + (size_t)1024 * LDF * 2 <= ((size_t)20 << 20), "wb");
constexpr size_t WB_WPT = 0, WB_L2W = (size_t)3840 * 2048 * 2, WB_RWO = WB_L2W + 3 * (size_t)1024 * 256 * 2;
constexpr size_t WB_WIT = 0, WB_AWO = (size_t)PW * 1024 * 2;
static_assert(OFF_RKV + 3 * SZ_B16 <= ((size_t)512 << 20), "ws");
static_assert(OFF_ACT + (size_t)MP * LDF * 2 <= ((size_t)500 << 20), "ws");
static_assert(WB_RWO + (size_t)1024 * 1024 * 2 <= SZ_WB, "wb");

__device__ __forceinline__ unsigned pk2(float a, float b) { return pg8::cvt_pk_bf16(a, b); }
__device__ __forceinline__ float bf_lo(unsigned u) { return __uint_as_float(u << 16); }
__device__ __forceinline__ float bf_hi(unsigned u) { return __uint_as_float(u & 0xffff0000u); }
__device__ __forceinline__ unsigned short f2h(float x) { _Float16 h = (_Float16)x; return __builtin_bit_cast(unsigned short, h); }
__device__ __forceinline__ float h2f(unsigned short u) { return (float)__builtin_bit_cast(_Float16, u); }
__device__ __forceinline__ void lds_wave_sync() { asm volatile("s_waitcnt lgkmcnt(0)" ::: "memory"); }
__device__ __forceinline__ float wave_sum(float v) {
#pragma unroll
    for (int o = 1; o < 64; o <<= 1) v += __shfl_xor(v, o);
    return v;
}
template <int CTRL> __device__ __forceinline__ float dppmov(float v) {
    return __builtin_bit_cast(float, __builtin_amdgcn_update_dpp(0, __builtin_bit_cast(int, v), CTRL, 0xF, 0xF, true));
}
__device__ __forceinline__ float row16_sum(float v) { v += dppmov<0xB1>(v); v += dppmov<0x4E>(v); v += dppmov<0x141>(v); v += dppmov<0x140>(v); return v; }
__device__ __forceinline__ float row16_max(float v) { v = fmaxf(v, dppmov<0xB1>(v)); v = fmaxf(v, dppmov<0x4E>(v)); v = fmaxf(v, dppmov<0x141>(v)); v = fmaxf(v, dppmov<0x140>(v)); return v; }
__device__ __forceinline__ float sigmoidf_(float x) { return 1.0f / (1.0f + __expf(-x)); }

__device__ __forceinline__ void tr_job(const float* W, int Ksrc, int Nsrc, int ldn, const float* kscale, int perm,
                                       bf16_t* WT, int ldk, int drow0, int dk0, int Npad, int Kpad, float* scr, int gw, int ngw, int lane, int& rot) {
    const int nblk = Npad / 32, nitems = (Kpad / 64) * nblk;
    const int first = (gw >= rot) ? (gw - rot) : (gw + ngw - rot);
    rot = (rot + nitems) % ngw;
    for (int it = first; it < nitems; it += ngw) {
        const int kb = it / nblk, nb = it % nblk, k0 = 64 * kb, n0 = 32 * nb;
        int ns0 = n0;
        if (perm) { const int pn = n0 >> 8, w = n0 & 255; ns0 = (w < 128) ? (128 * pn + w) : (FF + 128 * pn + (w - 128)); }
#pragma unroll
        for (int i = 0; i < 8; ++i) {
            const int kk = 8 * i + (lane >> 3), k = k0 + kk, nl = 4 * (lane & 7), n = ns0 + nl;
            f32x4 v = (f32x4){0.f, 0.f, 0.f, 0.f};
            if (k < Ksrc && n < Nsrc) { v = *(const f32x4*)(W + (size_t)k * ldn + n); if (kscale) v = v * kscale[k]; }
            float* sp = scr + kk * 33 + nl;
            sp[0] = v.x; sp[1] = v.y; sp[2] = v.z; sp[3] = v.w;
        }
        lds_wave_sync();
        const int c = lane & 7;
#pragma unroll
        for (int j = 0; j < 4; ++j) {
            const int n = (lane >> 3) + 8 * j; const float* s = scr + (8 * c) * 33 + n;
            u32x4 o; o.x = pk2(s[0 * 33], s[1 * 33]); o.y = pk2(s[2 * 33], s[3 * 33]); o.z = pk2(s[4 * 33], s[5 * 33]); o.w = pk2(s[6 * 33], s[7 * 33]);
            *(u32x4*)(WT + (size_t)(drow0 + n0 + n) * ldk + dk0 + k0 + 8 * c) = o;
        }
        lds_wave_sync();
    }
}

template <int MODE>
__device__ __forceinline__ void norm_phase(const Params& p, const float* g, float* H, bf16_t* OUT, int gw, int ngw, int lane, const float* PART = nullptr, int ns = 0) {
    constexpr int LDO = (MODE == 2) ? 2 * D : D;
    constexpr int NR = (MODE == 2) ? 2 : 4;
    f32x4 gv[4];
#pragma unroll
    for (int j = 0; j < 4; ++j) gv[j] = *(const f32x4*)(g + 4 * (lane + 64 * j));
    for (int r0 = gw; r0 < MP; r0 += NR * ngw) {
        f32x4 v[NR][4], pv[NR][4];
        int rr[NR], tt[NR];
#pragma unroll
        for (int q = 0; q < NR; ++q) {
            const int r = r0 + q * ngw; rr[q] = r;
            const int rc = (r < M) ? r : 0;
            const int b = rc / T, t = rc - b * T; tt[q] = t;
            const float* src;
            if (MODE == 1) src = (t < NMETA) ? (p.in[1] + (size_t)t * D) : (p.in[0] + ((size_t)b * SEQ + (t - NMETA)) * D);
            else src = H + (size_t)rc * D;
#pragma unroll
            for (int j = 0; j < 4; ++j) v[q][j] = *(const f32x4*)(src + 4 * (lane + 64 * j));
            if (MODE == 0 && ns > 0 && r >= MMAIN && r < M) {
                for (int s = 0; s < ns; ++s)
#pragma unroll
                    for (int j = 0; j < 4; ++j) v[q][j] = v[q][j] + *(const f32x4*)(PART + ((size_t)s * (M - MMAIN) + (r - MMAIN)) * D + 4 * (lane + 64 * j));
#pragma unroll
                for (int j = 0; j < 4; ++j) *(f32x4*)(H + (size_t)r * D + 4 * (lane + 64 * j)) = v[q][j];
            }
            if (MODE == 2) {
                const float* ps = H + (size_t)(rc > 0 ? rc - 1 : 0) * D;
#pragma unroll
                for (int j = 0; j < 4; ++j) pv[q][j] = *(const f32x4*)(ps + 4 * (lane + 64 * j));
            }
        }
#pragma unroll
        for (int q = 0; q < NR; ++q) {
            const int r = rr[q];
            if (r >= MP) continue;
            bf16_t* orow = OUT + (size_t)r * LDO;
            if (r >= M) {
#pragma unroll
                for (int j = 0; j < 4; ++j) { *(u32x2*)(orow + 4 * (lane + 64 * j)) = (u32x2){0u, 0u}; if (MODE == 2) *(u32x2*)(orow + D + 4 * (lane + 64 * j)) = (u32x2){0u, 0u}; }
                continue;
            }
            float ss = 0.f;
#pragma unroll
            for (int j = 0; j < 4; ++j) ss += v[q][j].x * v[q][j].x + v[q][j].y * v[q][j].y + v[q][j].z * v[q][j].z + v[q][j].w * v[q][j].w;
            if (MODE == 1) {
#pragma unroll
                for (int j = 0; j < 4; ++j) *(f32x4*)(H + (size_t)r * D + 4 * (lane + 64 * j)) = v[q][j];
            }
            const float rstd = 1.0f / sqrtf(wave_sum(ss) * (1.0f / D) + 1e-6f);
#pragma unroll
            for (int j = 0; j < 4; ++j) v[q][j] = v[q][j] * rstd * gv[j];
            if (MODE == 2) {
                if (tt[q] > 0) {
                    float s2 = 0.f;
#pragma unroll
                    for (int j = 0; j < 4; ++j) s2 += pv[q][j].x * pv[q][j].x + pv[q][j].y * pv[q][j].y + pv[q][j].z * pv[q][j].z + pv[q][j].w * pv[q][j].w;
                    const float rp = 1.0f / sqrtf(wave_sum(s2) * (1.0f / D) + 1e-6f);
#pragma unroll
                    for (int j = 0; j < 4; ++j) pv[q][j] = pv[q][j] * rp * gv[j];
                } else {
#pragma unroll
                    for (int j = 0; j < 4; ++j) pv[q][j] = (f32x4){0.f, 0.f, 0.f, 0.f};
                }
#pragma unroll
                for (int j = 0; j < 4; ++j) { const f32x4 xx = pv[q][j] - v[q][j]; *(u32x2*)(orow + D + 4 * (lane + 64 * j)) = (u32x2){pk2(xx.x, xx.y), pk2(xx.z, xx.w)}; }
            }
#pragma unroll
            for (int j = 0; j < 4; ++j) *(u32x2*)(orow + 4 * (lane + 64 * j)) = (u32x2){pk2(v[q][j].x, v[q][j].y), pk2(v[q][j].z, v[q][j].w)};
        }
    }
}

struct EpiSwiGLU {
    static constexpr bool PERM = true, AFTER_DRAIN = false;
    bf16_t* O;
    __device__ __forceinline__ void operator()(const f32x4 (&acc)[2][2][4][2], const pg8::Unit& u, int wr, int wc, int fr, int fq) const {
        const int row0 = u.pm * 256 + wr * 64 + fr, col0 = u.pn * 128 + wc * 32 + 8 * fq;
#pragma unroll
        for (int ai = 0; ai < 2; ++ai)
#pragma unroll
            for (int m = 0; m < 4; ++m) {
                bf16_t* rowp = O + (size_t)(row0 + ai * 128 + m * 16) * LDF + col0;
                float o[8];
#pragma unroll
                for (int n = 0; n < 2; ++n)
#pragma unroll
                    for (int j = 0; j < 4; ++j) { const float gte = acc[ai][0][m][n][j], up = acc[ai][1][m][n][j]; o[4 * n + j] = gte * __builtin_amdgcn_rcpf(1.0f + __expf(-gte)) * up; }
                u32x4 w; w.x = pk2(o[0], o[1]); w.y = pk2(o[2], o[3]); w.z = pk2(o[4], o[5]); w.w = pk2(o[6], o[7]);
                *(u32x4*)rowp = w;
            }
    }
};
template <bool FINAL> struct EpiResid {
    static constexpr bool PERM = false, AFTER_DRAIN = false;
    float* H; float scale; float* out;
    __device__ __forceinline__ void operator()(const f32x4 (&acc)[2][2][4][2], const pg8::Unit& u, int wr, int wc, int fr, int fq) const {
        const int row0 = u.pm * 256 + wr * 64 + fr, col0 = u.pn * 256 + wc * 32 + 4 * fq;
#pragma unroll
        for (int ai = 0; ai < 2; ++ai)
#pragma unroll
            for (int m = 0; m < 4; ++m) {
                const int row = row0 + ai * 128 + m * 16;
                if (row < M) {
                    float* hp = H + (size_t)row * D + col0;
                    const int b = row / T, t = row - b * T;
                    float* op = FINAL ? (out + ((size_t)b * SEQ + (t - NMETA)) * D + col0) : nullptr;
#pragma unroll
                    for (int bj = 0; bj < 2; ++bj)
#pragma unroll
                        for (int n = 0; n < 2; ++n) {
                            f32x4 hv = *(const f32x4*)(hp + bj * 128 + n * 16); hv = hv + acc[ai][bj][m][n] * scale;
                            if (FINAL) { if (t >= NMETA) *(f32x4*)(op + bj * 128 + n * 16) = hv; }
                            else *(f32x4*)(hp + bj * 128 + n * 16) = hv;
                        }
                }
            }
    }
};
template <int mode> struct EpiBf {
    static constexpr bool PERM = true, AFTER_DRAIN = false;
    bf16_t* O0; bf16_t* O1; const float* bias; int ldo;
    template <int ACT> __device__ __forceinline__ void body(const f32x4 (&acc)[2][2][4][2], bf16_t* base, int ld, int row0, int col0) const {
#pragma unroll
        for (int ai = 0; ai < 2; ++ai)
#pragma unroll
            for (int m = 0; m < 4; ++m)
#pragma unroll
                for (int bj = 0; bj < 2; ++bj) {
                    bf16_t* rowp = base + (size_t)(row0 + ai * 128 + m * 16) * ld + col0 + bj * 128;
                    f32x4 v0 = acc[ai][bj][m][0] + (f32x4){0.f, 0.f, 0.f, 0.f}, v1 = acc[ai][bj][m][1] + (f32x4){0.f, 0.f, 0.f, 0.f};
                    if (mode >= 2) { v0 = v0 + *(const f32x4*)(bias + col0 + bj * 128); v1 = v1 + *(const f32x4*)(bias + col0 + bj * 128 + 4); }
#pragma unroll
                    for (int j = 0; j < 4; ++j) {
                        if (ACT == 1) { v0[j] = 1.0f - 2.0f / (__expf(2.0f * v0[j]) + 1.0f); v1[j] = 1.0f - 2.0f / (__expf(2.0f * v1[j]) + 1.0f); }
                        if (ACT == 2) { v0[j] = sigmoidf_(v0[j]); v1[j] = sigmoidf_(v1[j]); }
                        if (ACT == 3) { v0[j] = 0.6065306597f * sigmoidf_(v0[j]); v1[j] = 0.6065306597f * sigmoidf_(v1[j]); }
                    }
                    u32x4 w;
#ifdef PKRTZ
                    if (ACT == 3) { typedef _Float16 h2_ __attribute__((ext_vector_type(2))); h2_ q0 = __builtin_amdgcn_cvt_pkrtz(v0[0], v0[1]), q1 = __builtin_amdgcn_cvt_pkrtz(v0[2], v0[3]), q2 = __builtin_amdgcn_cvt_pkrtz(v1[0], v1[1]), q3 = __builtin_amdgcn_cvt_pkrtz(v1[2], v1[3]);
                        w.x = __builtin_bit_cast(unsigned, q0); w.y = __builtin_bit_cast(unsigned, q1); w.z = __builtin_bit_cast(unsigned, q2); w.w = __builtin_bit_cast(unsigned, q3); } else
#endif
                    if (ACT == 3) {
                        w.x = f2h(v0[0]) | ((unsigned)f2h(v0[1]) << 16); w.y = f2h(v0[2]) | ((unsigned)f2h(v0[3]) << 16);
                        w.z = f2h(v1[0]) | ((unsigned)f2h(v1[1]) << 16); w.w = f2h(v1[2]) | ((unsigned)f2h(v1[3]) << 16);
                    } else { w.x = pk2(v0[0], v0[1]); w.y = pk2(v0[2], v0[3]); w.z = pk2(v1[0], v1[1]); w.w = pk2(v1[2], v1[3]); }
                    *(u32x4*)rowp = w;
                }
    }
    __device__ __forceinline__ void operator()(const f32x4 (&acc)[2][2][4][2], const pg8::Unit& u, int wr, int wc, int fr, int fq) const {
        const int row0 = u.pm * 256 + wr * 64 + fr, cl = wc * 32 + 8 * fq;
        if (mode == 1) {
            if (u.pn < 12) body<0>(acc, O0 + (size_t)(u.pn >> 2) * ((size_t)MP * D), D, row0, (u.pn & 3) * 256 + cl);
            else if (u.pn == 12) body<1>(acc, O1, 256, row0, cl);
            else if (u.pn == 13) body<0>(acc, O1 + (size_t)MP * 256, 256, row0, cl);
            else body<2>(acc, O1 + (size_t)2 * MP * 256, 256, row0, cl);
        } else if (mode == 2) body<3>(acc, O0, ldo, row0, u.pn * 256 + cl);
        else if (mode == 3) body<2>(acc, O0, ldo, row0, u.pn * 256 + cl);
        else body<0>(acc, O0, ldo, row0, u.pn * 256 + cl);
    }
};

template <class Epi>
__device__ __forceinline__ void run_gemm(unsigned char* smem, const bf16_t* A, const bf16_t* Bt, int N, int K, const Epi E, int rot, int Mrows = MP, int ld = 0) {
    pg8::Gemm g; g.A = A; g.Bt = Bt; g.M = Mrows; g.N = N; g.K = K; g.ld = ld ? ld : K;
    pg8::StaticOrder S; S.init(Mrows, N, (int)gridDim.x, (int)((blockIdx.x + rot) % gridDim.x));
    pg8::gemm_phase<Epi, pg8::StaticOrder, false>((PG8_LAS unsigned char*)smem, g, S, E, nullptr);
    __syncthreads();
}

struct EpiTailPart {
    static constexpr bool PERM = false, AFTER_DRAIN = false;
    float* PART; float scale;
    __device__ __forceinline__ void operator()(const f32x4 (&acc)[2][2][4][2], const pg8::Unit& u, int wr, int wc, int fr, int fq) const {
        const int lrow0 = wr * 64 + fr, col0 = (u.pn & 3) * 256 + wc * 32 + 4 * fq;
        float* base = PART + (size_t)(u.pn >> 2) * ((size_t)(M - MMAIN) * D);
#pragma unroll
        for (int m = 0; m < 4; ++m) {
            const int lrow = lrow0 + m * 16;
            if (lrow < M - MMAIN) {
                float* hp = base + (size_t)lrow * D + col0;
#pragma unroll
                for (int bj = 0; bj < 2; ++bj)
#pragma unroll
                    for (int n = 0; n < 2; ++n) *(f32x4*)(hp + bj * 128 + n * 16) = acc[0][bj][m][n] * scale;
            }
        }
    }
};
__device__ __forceinline__ void run_gemm_tail(unsigned char* smem, const bf16_t* A, const bf16_t* Bt, int K, float* PART, float scale, int rot, int ld = 0) {
    if (!ld) ld = K;
    pg8::Gemm g; g.A = A + (size_t)MMAIN * ld; g.Bt = Bt; g.M = 256; g.N = D; g.K = 256; g.ld = ld;
    pg8::SplitKOrder S; S.init(4, K / 256, (int)gridDim.x, (int)((blockIdx.x + rot) % gridDim.x));
    EpiTailPart E; E.PART = PART; E.scale = scale;
    pg8::gemm_phase<EpiTailPart, pg8::SplitKOrder, false>((PG8_LAS unsigned char*)smem, g, S, E, nullptr);
    __syncthreads();
}

constexpr int SC_STEP = 356, SC_TC = 32;
__device__ __forceinline__ void scan_phase(const Params& p, unsigned char* ws, bf16_t* Y, unsigned char* smem) {
    float* buf = (float*)smem;
    float* ybuf = (float*)(smem + 2 * SC_TC * SC_STEP * 4);
    const bf16_t* Rr = (const bf16_t*)(ws + OFF_RKV); const bf16_t* Kr = Rr + (size_t)MP * D; const bf16_t* Vr = Kr + (size_t)MP * D;
    const bf16_t* As = (const bf16_t*)(ws + OFF_ASIG); const bf16_t* Eh = (const bf16_t*)(ws + OFF_E);
    int tid = threadIdx.x; asm volatile("" : "+v"(tid));
    const bool is_comp = tid < 256;
    const int sub = tid & 15, grp = (tid >> 4) & 15;
    constexpr int NCH = (T + SC_TC - 1) / SC_TC;
    typedef float f32x2_ __attribute__((ext_vector_type(2)));
    for (int item = blockIdx.x; item < 256; item += gridDim.x) {
        const int b = item >> 5, h = (item >> 1) & 15, half = item & 1;
        const int cb = h * 64 + 4 * sub;
        f32x4 kkc, kac, w0c, a0c;
        if (!is_comp) { kkc = *(const f32x4*)(p.in[18] + cb); kac = *(const f32x4*)(p.in[19] + cb); w0c = *(const f32x4*)(p.in[10] + cb); a0c = *(const f32x4*)(p.in[13] + cb); }
        auto stage2 = [&](int c, float* dstb) {
            u32x2 pr[2], pk[2], pa[2], pe[2], pv[2];
#pragma unroll
            for (int q = 0; q < 2; ++q) {
                const int t = c * SC_TC + grp + 16 * q;
                pr[q] = (u32x2){0u, 0u}; pk[q] = pr[q]; pa[q] = pr[q]; pe[q] = pr[q]; pv[q] = pr[q];
                if (t < T) {
                    const size_t ro = ((size_t)b * T + t) * D;
                    pr[q] = *(const u32x2*)(Rr + ro + cb); pk[q] = *(const u32x2*)(Kr + ro + cb); pa[q] = *(const u32x2*)(As + ro + cb); pe[q] = *(const u32x2*)(Eh + ro + cb);
                    if (sub < 8) pv[q] = *(const u32x2*)(Vr + ro + h * 64 + half * 32 + 4 * sub);
                }
            }
#pragma unroll
            for (int q = 0; q < 2; ++q) {
                float* sp = dstb + (grp + 16 * q) * SC_STEP;
                const f32x4 r4 = (f32x4){bf_lo(pr[q].x), bf_hi(pr[q].x), bf_lo(pr[q].y), bf_hi(pr[q].y)};
                const f32x4 k4 = (f32x4){bf_lo(pk[q].x), bf_hi(pk[q].x), bf_lo(pk[q].y), bf_hi(pk[q].y)};
                f32x4 a4 = (f32x4){bf_lo(pa[q].x), bf_hi(pa[q].x), bf_lo(pa[q].y), bf_hi(pa[q].y)} + a0c;
                a4.x = sigmoidf_(a4.x); a4.y = sigmoidf_(a4.y); a4.z = sigmoidf_(a4.z); a4.w = sigmoidf_(a4.w);
                f32x4 e4 = (f32x4){bf_lo(pe[q].x), bf_hi(pe[q].x), bf_lo(pe[q].y), bf_hi(pe[q].y)} + w0c;
                e4.x = 0.6065306597f * sigmoidf_(e4.x); e4.y = 0.6065306597f * sigmoidf_(e4.y); e4.z = 0.6065306597f * sigmoidf_(e4.z); e4.w = 0.6065306597f * sigmoidf_(e4.w);
                f32x4 kk = k4 * kkc;
                const float ss = row16_sum(kk.x * kk.x + kk.y * kk.y + kk.z * kk.z + kk.w * kk.w);
                const float inv = 1.0f / fmaxf(sqrtf(ss), 1e-12f);
                kk = kk * inv;
                const f32x4 kf = k4 * (1.0f + (a4 - 1.0f) * kac);
                f32x4 w; w.x = __expf(-e4.x); w.y = __expf(-e4.y); w.z = __expf(-e4.z); w.w = __expf(-e4.w);
                const f32x4 Bv = kk * a4, WR = w * r4;
                const float br = row16_sum(Bv.x * r4.x + Bv.y * r4.y + Bv.z * r4.z + Bv.w * r4.w);
                const float kr = row16_sum(kf.x * r4.x + kf.y * r4.y + kf.z * r4.z + kf.w * r4.w);
                *(f32x4*)(sp + 4 * sub) = -kk; *(f32x4*)(sp + 64 + 4 * sub) = WR; *(f32x4*)(sp + 128 + 4 * sub) = w; *(f32x4*)(sp + 192 + 4 * sub) = Bv; *(f32x4*)(sp + 256 + 4 * sub) = kf;
                if (sub < 8) *(f32x4*)(sp + 320 + 4 * sub) = (f32x4){bf_lo(pv[q].x), bf_hi(pv[q].x), bf_lo(pv[q].y), bf_hi(pv[q].y)};
                if (sub == 0) { sp[352] = br; sp[353] = kr; }
            }
        };
        auto yout = [&](int c) {
            const int st = (tid - 256) >> 3, r4i = (tid & 7) * 4, t = c * SC_TC + st;
            if (t < T) {
                const f32x4 yv = *(const f32x4*)(ybuf + (c & 1) * (SC_TC * 32) + st * 32 + r4i);
                *(u32x2*)(Y + ((size_t)b * T + t) * D + h * 64 + half * 32 + r4i) = (u32x2){pk2(yv.x, yv.y), pk2(yv.z, yv.w)};
            }
        };
        if (!is_comp) stage2(0, buf);
        __syncthreads();
        f32x2_ Sa01 = (f32x2_){0.f, 0.f}, Sa23 = Sa01, Sb01 = Sa01, Sb23 = Sa01;
        for (int c = 0; c < NCH; ++c) {
            if (is_comp) {
                const int nst = (T - c * SC_TC) < SC_TC ? (T - c * SC_TC) : SC_TC;
                const float* cbuf = buf + (c & 1) * (SC_TC * SC_STEP); float* yb = ybuf + (c & 1) * (SC_TC * 32);
#define SC_LDO(X, s_) do { const float* sp_ = cbuf + (s_) * SC_STEP; \
                    A4##X = *(const f32x4*)(sp_ + 4 * sub); WR4##X = *(const f32x4*)(sp_ + 64 + 4 * sub); W4##X = *(const f32x4*)(sp_ + 128 + 4 * sub); \
                    B4##X = *(const f32x4*)(sp_ + 192 + 4 * sub); K4##X = *(const f32x4*)(sp_ + 256 + 4 * sub); \
                    via##X = sp_[320 + grp]; vib##X = sp_[336 + grp]; bk##X = *(const f32x2_*)(sp_ + 352); } while (0)
#define SC_STEPF(X, s_) do { \
                    const f32x2_ A01 = (f32x2_){A4##X.x, A4##X.y}, A23 = (f32x2_){A4##X.z, A4##X.w}, R01 = (f32x2_){WR4##X.x, WR4##X.y}, R23 = (f32x2_){WR4##X.z, WR4##X.w}; \
                    const f32x2_ sa2 = Sa01 * A01 + Sa23 * A23, sb2 = Sb01 * A01 + Sb23 * A23; \
                    const f32x2_ ya2 = Sa01 * R01 + Sa23 * R23, yb2 = Sb01 * R01 + Sb23 * R23; \
                    const float sa = row16_sum(sa2.x + sa2.y), sb = row16_sum(sb2.x + sb2.y), ypa = row16_sum(ya2.x + ya2.y), ypb = row16_sum(yb2.x + yb2.y); \
                    const f32x2_ W01 = (f32x2_){W4##X.x, W4##X.y}, W23 = (f32x2_){W4##X.z, W4##X.w}, B01 = (f32x2_){B4##X.x, B4##X.y}, B23 = (f32x2_){B4##X.z, B4##X.w}, K01 = (f32x2_){K4##X.x, K4##X.y}, K23 = (f32x2_){K4##X.z, K4##X.w}; \
                    const f32x2_ sav = (f32x2_){sa, sa}, sbv = (f32x2_){sb, sb}, vav = (f32x2_){via##X, via##X}, vbv = (f32x2_){vib##X, vib##X}; \
                    Sa01 = Sa01 * W01 + (sav * B01 + vav * K01); Sa23 = Sa23 * W23 + (sav * B23 + vav * K23); \
                    Sb01 = Sb01 * W01 + (sbv * B01 + vbv * K01); Sb23 = Sb23 * W23 + (sbv * B23 + vbv * K23); \
                    if (sub == 0) { yb[(s_) * 32 + grp] = ypa + sa * bk##X.x + via##X * bk##X.y; yb[(s_) * 32 + 16 + grp] = ypb + sb * bk##X.x + vib##X * bk##X.y; } } while (0)
                f32x4 A4a, WR4a, W4a, B4a, K4a, A4b, WR4b, W4b, B4b, K4b; float viaa, viba, viab, vibb; f32x2_ bka, bkb;
                SC_LDO(a, 0);
                for (int s = 0; s < nst; s += 2) {
                    SC_LDO(b, s + 1);
                    SC_STEPF(a, s);
                    if (s + 2 < nst) SC_LDO(a, s + 2);
                    SC_STEPF(b, s + 1);
                }
            } else {
                if (c > 0) yout(c - 1);
                if (c + 1 < NCH) stage2(c + 1, buf + ((c + 1) & 1) * (SC_TC * SC_STEP));
            }
            __syncthreads();
        }
        if (!is_comp) yout(NCH - 1);
        __syncthreads();
    }
}

__device__ __forceinline__ void rwkv_post_phase(const Params& p, unsigned char* ws, bf16_t* Y, int gw, int ngw, int lane) {
    const bf16_t* Rr = (const bf16_t*)(ws + OFF_RKV); const bf16_t* Kr = Rr + (size_t)MP * D; const bf16_t* Vr = Kr + (size_t)MP * D;
    const bf16_t* As = (const bf16_t*)(ws + OFF_ASIG); const bf16_t* G = (const bf16_t*)(ws + OFF_E);
    const int grp = lane >> 4, sub = lane & 15;
    constexpr int NI = 4;
    for (int w0 = gw; w0 < MP * 4; w0 += NI * ngw) {
        u32x2 uy[NI], ur[NI], uk[NI], uv[NI], ua[NI], ug[NI]; size_t os[NI]; int c0s[NI], st[NI];
#pragma unroll
        for (int i = 0; i < NI; ++i) {
            const int w = w0 + i * ngw, wc = (w < MP * 4) ? w : w0;
            const int row = wc >> 2, q = wc & 3; c0s[i] = (q * 4 + grp) * 64 + 4 * sub; os[i] = (size_t)row * D + c0s[i];
            st[i] = (w >= MP * 4) ? 2 : ((row >= M) ? 1 : 0);
            const size_t o = (row >= M) ? (size_t)c0s[i] : os[i];
            uy[i] = *(const u32x2*)(Y + o); ur[i] = *(const u32x2*)(Rr + o); uk[i] = *(const u32x2*)(Kr + o); uv[i] = *(const u32x2*)(Vr + o); ua[i] = *(const u32x2*)(As + o); ug[i] = *(const u32x2*)(G + o);
        }
#pragma unroll
        for (int i = 0; i < NI; ++i) {
            const int c0 = c0s[i];
            const f32x4 y = (f32x4){bf_lo(uy[i].x), bf_hi(uy[i].x), bf_lo(uy[i].y), bf_hi(uy[i].y)}, r = (f32x4){bf_lo(ur[i].x), bf_hi(ur[i].x), bf_lo(ur[i].y), bf_hi(ur[i].y)};
            const f32x4 k = (f32x4){bf_lo(uk[i].x), bf_hi(uk[i].x), bf_lo(uk[i].y), bf_hi(uk[i].y)}, v = (f32x4){bf_lo(uv[i].x), bf_hi(uv[i].x), bf_lo(uv[i].y), bf_hi(uv[i].y)};
            f32x4 a = (f32x4){bf_lo(ua[i].x), bf_hi(ua[i].x), bf_lo(ua[i].y), bf_hi(ua[i].y)} + *(const f32x4*)(p.in[13] + c0);
            a.x = sigmoidf_(a.x); a.y = sigmoidf_(a.y); a.z = sigmoidf_(a.z); a.w = sigmoidf_(a.w);
            const f32x4 g = (f32x4){bf_lo(ug[i].x), bf_hi(ug[i].x), bf_lo(ug[i].y), bf_hi(ug[i].y)};
            const f32x4 kac = *(const f32x4*)(p.in[19] + c0), rkc = *(const f32x4*)(p.in[20] + c0), lg = *(const f32x4*)(p.in[21] + c0), lb = *(const f32x4*)(p.in[22] + c0);
            const f32x4 kf = k * (1.0f + (a - 1.0f) * kac);
            const f32x4 t3 = r * kf * rkc;
            const float rk = row16_sum(t3.x + t3.y + t3.z + t3.w);
            const float mu = row16_sum(y.x + y.y + y.z + y.w) * (1.0f / 64.0f);
            const f32x4 dlt = y - mu;
            const float var = row16_sum(dlt.x * dlt.x + dlt.y * dlt.y + dlt.z * dlt.z + dlt.w * dlt.w) * (1.0f / 64.0f);
            const float rs = 1.0f / sqrtf(var + 64e-5f);
            const f32x4 z = ((dlt * rs) * lg + lb + v * rk) * g;
            if (st[i] == 0) *(u32x2*)(Y + os[i]) = (u32x2){pk2(z.x, z.y), pk2(z.z, z.w)};
            else if (st[i] == 1) *(u32x2*)(Y + os[i]) = (u32x2){0u, 0u};
        }
    }
}

__device__ __forceinline__ void rope_table_phase(const Params& p, float* TAB, int gtid, int ngt) {
    for (int i = gtid; i < T * 8; i += ngt) {
        const int t = i >> 3, k = i & 7;
        const float ang = (float)t * p.inv[k];
        double rev = (double)ang * 0.15915494309189535; rev -= rint(rev);
        const float rf = (float)rev;
        TAB[t * 16 + k] = __builtin_amdgcn_cosf(rf); TAB[t * 16 + 8 + k] = __builtin_amdgcn_sinf(rf);
    }
}
__device__ __forceinline__ void attn_post_phase(const Params& p, bf16_t* P, const float* TAB, unsigned char* Q8, unsigned char* K8, int gw, int ngw, int lane) {
    const int grp = lane >> 4, sub = lane & 15;
    const f32x4 qg = *(const f32x4*)(p.in[24] + 4 * sub), kg = *(const f32x4*)(p.in[25] + 4 * sub);
    constexpr int NI = 8;
    for (int w0 = gw; w0 < M * 8; w0 += NI * ngw) {
        u32x2 raw[NI]; bf16_t* ptrs[NI]; int us[NI], ts[NI];
#pragma unroll
        for (int i = 0; i < NI; ++i) {
            const int w = w0 + i * ngw, wc = (w < M * 8) ? w : w0;
            const int row = wc >> 3; int q4 = wc & 7; if (q4 >= 5) q4 += 1;
            us[i] = (w < M * 8) ? (4 * q4 + grp) : 99; ts[i] = row % T;
            ptrs[i] = P + (size_t)row * PW + 64 * (4 * q4 + grp) + 4 * sub;
            raw[i] = *(const u32x2*)ptrs[i];
        }
#pragma unroll
        for (int i = 0; i < NI; ++i) {
            const int u = us[i], t = ts[i];
            f32x4 x = (f32x4){bf_lo(raw[i].x), bf_hi(raw[i].x), bf_lo(raw[i].y), bf_hi(raw[i].y)};
            const bool isq = u < 16, isk = (u >= 16) && (u < 20), dorope = (u < 20) || (u >= 24 && u <= 32);
            const float ss = row16_sum(x.x * x.x + x.y * x.y + x.z * x.z + x.w * x.w) * (1.0f / 64.0f);
            if (isq || isk) { const float rs = 1.0f / sqrtf(ss + 1e-6f); x = x * rs * (isq ? qg : kg); }
            f32x4 xp; xp.x = dppmov<0x4E>(x.x); xp.y = dppmov<0x4E>(x.y); xp.z = dppmov<0x4E>(x.z); xp.w = dppmov<0x4E>(x.w);
            if (dorope && sub < 4) {
                const float* tb = TAB + t * 16 + (sub & 1) * 4;
                const f32x4 c = *(const f32x4*)tb, s = *(const f32x4*)(tb + 8);
                x = (sub < 2) ? (x * c - xp * s) : (x * c + xp * s);
            }
            if (u == 33) { if (sub < 2) x = x * 0.04419417382f; }
            if (u < 34) *(u32x2*)ptrs[i] = (u32x2){pk2(x.x, x.y), pk2(x.z, x.w)};
            if (u < 20) {
                int w8 = __builtin_amdgcn_cvt_pk_fp8_f32(x.x, x.y, 0, false); w8 = __builtin_amdgcn_cvt_pk_fp8_f32(x.z, x.w, w8, true);
                const size_t row_ = (size_t)(ptrs[i] - P) / PW;
                if (u < 16) *(int*)(Q8 + row_ * 1024 + u * 64 + 4 * sub) = w8; else *(int*)(K8 + row_ * 256 + (u - 16) * 64 + 4 * sub) = w8;
            }
        }
    }
}

constexpr int AT_WAVE_LDS = 16448 + 512;
__device__ __forceinline__ void attn_main_phase(const bf16_t* P, const unsigned char* Q8, const unsigned char* K8, bf16_t* AO, unsigned char* smem, int wave, int lane_in, int bid, int nblk) {
    float* sc = (float*)(smem + wave * AT_WAVE_LDS);
    unsigned short* idxl = (unsigned short*)(smem + wave * AT_WAVE_LDS + 16448);
    const int b = bid & 7;
    const float NEG_INF = -__builtin_huge_valf();
    const bf16_t* pb = P + (size_t)b * T * PW;
    for (int ug = (bid >> 3); ug < T / 8; ug += (nblk >> 3)) {
        int lane = lane_in; asm volatile("" : "+v"(lane));
        const int n15 = lane & 15, kq = lane >> 4;
        const int t0 = ug * 8, t = t0 + wave;
        const size_t row = (size_t)b * T + t;
        const bf16_t* prow = P + row * PW;
        int nsel;
        if (t0 >= 256) {
            nsel = 256;
            bf16x8 ia[4][2]; float w4[4][4];
#pragma unroll
            for (int mt = 0; mt < 4; ++mt) {
                const bf16_t* qp = pb + (size_t)(t0 + 2 * mt + (n15 >> 3)) * PW + 1536 + (n15 & 7) * 64 + kq * 8;
                ia[mt][0] = *(const bf16x8*)qp; ia[mt][1] = *(const bf16x8*)(qp + 32);
                const u32x2 wr = *(const u32x2*)(pb + (size_t)(t0 + 2 * mt + (kq >> 1)) * PW + 2112 + 4 * (kq & 1));
                w4[mt][0] = bf_lo(wr.x); w4[mt][1] = bf_hi(wr.x); w4[mt][2] = bf_lo(wr.y); w4[mt][3] = bf_hi(wr.y);
            }
            const int ntb = ((t0 + 7) >> 4) + 1;
            auto ldk = [&](bf16x8& d0, bf16x8& d1, int kt) { const bf16_t* kb = pb + (size_t)(16 * kt + n15) * PW + 2048 + kq * 8; d0 = *(const bf16x8*)kb; d1 = *(const bf16x8*)(kb + 32); };
            auto cmp = [&](const bf16x8& d0, const bf16x8& d1, int kt) {
#pragma unroll
                for (int mt = 0; mt < 4; ++mt) {
                    f32x4 acc = (f32x4){0.f, 0.f, 0.f, 0.f};
                    acc = __builtin_amdgcn_mfma_f32_16x16x32_bf16(ia[mt][0], d0, acc, 0, 0, 0);
                    acc = __builtin_amdgcn_mfma_f32_16x16x32_bf16(ia[mt][1], d1, acc, 0, 0, 0);
                    float ps = w4[mt][0] * fmaxf(acc[0], 0.f) + w4[mt][1] * fmaxf(acc[1], 0.f) + w4[mt][2] * fmaxf(acc[2], 0.f) + w4[mt][3] * fmaxf(acc[3], 0.f);
                    ps += __shfl_xor(ps, 16);
                    if ((kq & 1) == 0) ((float*)(smem + (2 * mt + (kq >> 1)) * AT_WAVE_LDS))[16 * kt + n15] = ps;
                }
            };
            bf16x8 xa0, xa1, xb0, xb1, xc0, xc1, xd0, xd1;
            int kt = wave;
            if (kt < ntb) ldk(xa0, xa1, kt);
            if (kt + 8 < ntb) ldk(xb0, xb1, kt + 8);
            if (kt + 16 < ntb) ldk(xc0, xc1, kt + 16);
            for (; kt < ntb; kt += 32) {
                if (kt + 24 < ntb) ldk(xd0, xd1, kt + 24);
                cmp(xa0, xa1, kt);
                if (kt + 32 < ntb) ldk(xa0, xa1, kt + 32);
                if (kt + 8 < ntb) cmp(xb0, xb1, kt + 8);
                if (kt + 40 < ntb) ldk(xb0, xb1, kt + 40);
                if (kt + 16 < ntb) cmp(xc0, xc1, kt + 16);
                if (kt + 48 < ntb) ldk(xc0, xc1, kt + 48);
                if (kt + 24 < ntb) cmp(xd0, xd1, kt + 24);
            }
            __syncthreads();
            unsigned key[65];
#pragma unroll
            for (int r = 0; r < 65; ++r) {
                const int e = r * 64 + lane;
                unsigned uu = __float_as_uint(sc[e]);
                if (uu == 0x80000000u) uu = 0u;
                uu = (uu & 0x80000000u) ? ~uu : (uu | 0x80000000u);
                key[r] = (e <= t) ? uu : 0u;
            }
            unsigned Tk = 0u;
            for (int bit = 31; bit >= 16; --bit) {
                const unsigned cand = Tk | (1u << bit);
                int cnt = 0;
#pragma unroll
                for (int gi = 0; gi < 5; ++gi) {
                    if (gi * 832 <= t) {
#pragma unroll
                        for (int rr = 0; rr < 13; ++rr) cnt += __popcll(__ballot(key[gi * 13 + rr] >= cand));
                    }
                }
                if (cnt >= 256) Tk = cand;
            }
            {
                const unsigned up = Tk + 0x10000u, hsel = Tk >> 16;
                int c_hi = 0, nc = 0;
                unsigned* cl = (unsigned*)sc;
                lds_wave_sync();
#pragma unroll
                for (int r = 0; r < 65; ++r) {
                    const bool hi = (up != 0u) && (key[r] >= up), cd = (key[r] >> 16) == hsel;
                    c_hi += __popcll(__ballot(hi));
                    const unsigned long long mc = __ballot(cd);
                    const int pos = nc + (int)__builtin_amdgcn_mbcnt_hi((unsigned)(mc >> 32), __builtin_amdgcn_mbcnt_lo((unsigned)mc, 0u));
                    if (cd) cl[pos] = key[r] & 0xffffu;
                    nc += __popcll(mc);
                }
                lds_wave_sync();
                const int nch = (nc + 63) >> 6;
                unsigned L = 0u;
                for (int bit = 15; bit >= 0; --bit) {
                    const unsigned cand = L | (1u << bit);
                    int cnt = c_hi;
                    for (int i = 0; i < nch; ++i) { const int ix = i * 64 + lane; const unsigned v = cl[ix]; cnt += __popcll(__ballot((ix < nc) && (v >= cand))); }
                    if (cnt >= 256) L = cand;
                }
                Tk |= L;
            }
            int ngt = 0;
#pragma unroll
            for (int r = 0; r < 65; ++r) ngt += __popcll(__ballot(key[r] > Tk));
            const int need = 256 - ngt;
            lds_wave_sync();
            int pg = 0, pe = 0;
#pragma unroll
            for (int r = 0; r < 65; ++r) {
                const int e = r * 64 + lane;
                const bool gt = key[r] > Tk, eq = key[r] == Tk;
                const unsigned long long mg = __ballot(gt), me = __ballot(eq);
                const int og = pg + (int)__builtin_amdgcn_mbcnt_hi((unsigned)(mg >> 32), __builtin_amdgcn_mbcnt_lo((unsigned)mg, 0u));
                const int oe = pe + (int)__builtin_amdgcn_mbcnt_hi((unsigned)(me >> 32), __builtin_amdgcn_mbcnt_lo((unsigned)me, 0u));
                if (gt) idxl[og] = (unsigned short)e;
                if (eq && oe < need) idxl[ngt + oe] = (unsigned short)e;
                pg += __popcll(mg); pe += __popcll(me);
            }
        } else {
            nsel = t + 1;
#pragma unroll
            for (int j = 0; j < 4; ++j) { const int e = j * 64 + lane; idxl[e] = (unsigned short)(e < t ? e : t); }
        }
        lds_wave_sync();
        const int ntile = (nsel + 15) >> 4;
        typedef long l2_ __attribute__((ext_vector_type(2)));
        const l2_ qv = *(const l2_*)(Q8 + row * 1024 + n15 * 64 + kq * 16);
        const unsigned char* pk8 = K8 + (size_t)b * T * 256;
        f32x4 mx4 = (f32x4){NEG_INF, NEG_INF, NEG_INF, NEG_INF};
        {
            auto ldt = [&](l2_ (&d)[4], int kt) {
                const int krow = idxl[16 * kt + n15];
                const unsigned char* kb = pk8 + (size_t)krow * 256 + kq * 16;
#pragma unroll
                for (int g = 0; g < 4; ++g) d[g] = *(const l2_*)(kb + 64 * g);
            };
            auto cmt = [&](const l2_ (&d)[4], int kt) {
                const int j = 16 * kt + n15;
                f32x4 a0 = (f32x4){0.f, 0.f, 0.f, 0.f}, a1 = a0, a2 = a0, a3 = a0;
                a0 = __builtin_amdgcn_mfma_f32_16x16x32_fp8_fp8(qv.x, d[0].x, a0, 0, 0, 0); a0 = __builtin_amdgcn_mfma_f32_16x16x32_fp8_fp8(qv.y, d[0].y, a0, 0, 0, 0);
                a1 = __builtin_amdgcn_mfma_f32_16x16x32_fp8_fp8(qv.x, d[1].x, a1, 0, 0, 0); a1 = __builtin_amdgcn_mfma_f32_16x16x32_fp8_fp8(qv.y, d[1].y, a1, 0, 0, 0);
                a2 = __builtin_amdgcn_mfma_f32_16x16x32_fp8_fp8(qv.x, d[2].x, a2, 0, 0, 0); a2 = __builtin_amdgcn_mfma_f32_16x16x32_fp8_fp8(qv.y, d[2].y, a2, 0, 0, 0);
                a3 = __builtin_amdgcn_mfma_f32_16x16x32_fp8_fp8(qv.x, d[3].x, a3, 0, 0, 0); a3 = __builtin_amdgcn_mfma_f32_16x16x32_fp8_fp8(qv.y, d[3].y, a3, 0, 0, 0);
                f32x4 sel = (kq == 0) ? a0 : ((kq == 1) ? a1 : ((kq == 2) ? a2 : a3));
#pragma unroll
                for (int r = 0; r < 4; ++r) { sel[r] = (j < nsel) ? sel[r] * 0.125f : NEG_INF; mx4[r] = fmaxf(mx4[r], sel[r]); }
                *(f32x4*)(sc + j * 16 + 4 * kq) = sel;
            };
            l2_ ka[4], kb2[4], kc[4];
            ldt(ka, 0);
            if (1 < ntile) ldt(kb2, 1);
            for (int kt = 0; kt < ntile; kt += 3) {
                if (kt + 2 < ntile) ldt(kc, kt + 2);
                cmt(ka, kt);
                if (kt + 1 < ntile) { if (kt + 3 < ntile) ldt(ka, kt + 3); cmt(kb2, kt + 1); }
                if (kt + 2 < ntile) { if (kt + 4 < ntile) ldt(kb2, kt + 4); cmt(kc, kt + 2); }
            }
        }
#pragma unroll
        for (int r = 0; r < 4; ++r) mx4[r] = row16_max(mx4[r]);
        f32x4 sm4 = (f32x4){0.f, 0.f, 0.f, 0.f};
        for (int kt = 0; kt < ntile; ++kt) {
            float* pp = sc + (16 * kt + n15) * 16 + 4 * kq;
            f32x4 v = *(const f32x4*)pp;
#pragma unroll
            for (int r = 0; r < 4; ++r) { v[r] = __expf(v[r] - mx4[r]); sm4[r] += v[r]; }
            *(f32x4*)pp = v;
        }
#pragma unroll
        for (int r = 0; r < 4; ++r) sm4[r] = 1.0f / row16_sum(sm4[r]);
        float* invl = sc + 4096;
        if (n15 == 0) *(f32x4*)(invl + 4 * kq) = sm4;
        lds_wave_sync();
        const int kp = lane >> 5, pg = (lane >> 3) & 3, d8 = lane & 7;
        typedef float f32x2p __attribute__((ext_vector_type(2)));
        f32x2p o[4][4];
#pragma unroll
        for (int hh = 0; hh < 4; ++hh)
#pragma unroll
            for (int e = 0; e < 4; ++e) o[hh][e] = (f32x2p){0.f, 0.f};
        {
            auto ldv = [&](u32x4 (&d)[4], int jp0) {
#pragma unroll
                for (int i = 0; i < 4; ++i) {
                    const int krow = idxl[2 * (jp0 + i) + kp];
                    d[i] = *(const u32x4*)(pb + (size_t)krow * PW + 1280 + pg * 64 + d8 * 8);
                }
            };
            auto cmv = [&](const u32x4 (&d)[4], int jp0) {
#pragma unroll
                for (int i = 0; i < 4; ++i) {
                    const int j = 2 * (jp0 + i) + kp;
                    const f32x4 p4 = *(const f32x4*)(sc + j * 16 + 4 * pg);
                    const f32x2p v[4] = {(f32x2p){bf_lo(d[i].x), bf_hi(d[i].x)}, (f32x2p){bf_lo(d[i].y), bf_hi(d[i].y)}, (f32x2p){bf_lo(d[i].z), bf_hi(d[i].z)}, (f32x2p){bf_lo(d[i].w), bf_hi(d[i].w)}};
#pragma unroll
                    for (int hh = 0; hh < 4; ++hh) {
                        const f32x2p ps = (f32x2p){p4[hh], p4[hh]};
#pragma unroll
                        for (int e = 0; e < 4; ++e) o[hh][e] = o[hh][e] + ps * v[e];
                    }
                }
            };
            u32x4 va[4], vb2[4];
            const int npairs = 8 * ntile;
            ldv(va, 0);
            for (int c0 = 0; c0 < npairs; c0 += 8) {
                ldv(vb2, c0 + 4);
                cmv(va, c0);
                if (c0 + 8 < npairs) ldv(va, c0 + 8);
                cmv(vb2, c0 + 4);
            }
        }
        {
            const f32x4 iv = *(const f32x4*)(invl + 4 * pg);
#pragma unroll
            for (int hh = 0; hh < 4; ++hh) {
                float r[8];
#pragma unroll
                for (int e = 0; e < 4; ++e) { r[2 * e] = (o[hh][e].x + __shfl_xor(o[hh][e].x, 32)) * iv[hh]; r[2 * e + 1] = (o[hh][e].y + __shfl_xor(o[hh][e].y, 32)) * iv[hh]; }
                if (lane < 32) *(u32x4*)(AO + row * D + (4 * pg + hh) * 64 + 8 * d8) = (u32x4){pk2(r[0], r[1]), pk2(r[2], r[3]), pk2(r[4], r[5]), pk2(r[6], r[7])};
            }
        }
        __syncthreads();
    }
}

__device__ __forceinline__ void tail_reduce(float* H, const float* PART, int ns, int gtid, int ngt) {
    for (int i = gtid; i < (M - MMAIN) * D / 4; i += ngt) {
        f32x4 v = *(const f32x4*)(H + (size_t)MMAIN * D + (size_t)i * 4);
        for (int s = 0; s < ns; ++s) v = v + *(const f32x4*)(PART + (size_t)s * ((size_t)(M - MMAIN) * D) + (size_t)i * 4);
        *(f32x4*)(H + (size_t)MMAIN * D + (size_t)i * 4) = v;
    }
}

struct Ctx { int tid, lane, wave, gw, ngw, bid, nblk; };
__device__ __forceinline__ Ctx mkctx() {
    int tid = threadIdx.x, bid = blockIdx.x, nb = gridDim.x;
    asm volatile("" : "+v"(tid)); asm volatile("" : "+s"(bid)); asm volatile("" : "+s"(nb));
    Ctx c; c.tid = tid; c.lane = tid & 63; c.wave = __builtin_amdgcn_readfirstlane(tid >> 6); c.bid = bid; c.nblk = nb; c.gw = bid * 8 + c.wave; c.ngw = nb * 8; return c;
}
template <class T_> __device__ __forceinline__ T_* launder(T_* ptr) { return ptr; }

#ifdef DUP_SYNC
#define EXTRA_SYNC() grid.sync()
#else
#define EXTRA_SYNC()
#endif
#define PHASE_END() do { if (phase == 0) grid.sync(); else xcd_barrier(xb); EXTRA_SYNC(); ++phase; if (STOP_AFTER == phase) { dump_h(p, H); return; } } while (0)
__device__ __forceinline__ void dump_h(const Params& p, const float* H) {
    for (size_t i = (size_t)blockIdx.x * 512 + threadIdx.x; i < (size_t)NB * SEQ * D / 4; i += (size_t)gridDim.x * 512) {
        const size_t e = i * 4, orow = e / D, c = e % D, b_ = orow / SEQ, t_ = orow % SEQ; *(f32x4*)(p.out + e) = *(const f32x4*)(H + ((size_t)b_ * T + t_ + NMETA) * D + c); }
}

__global__ void __launch_bounds__(512, 2) fwd_mega(Params p) {
    extern __shared__ __attribute__((aligned(16))) unsigned char smem[];
    cg::grid_group grid = cg::this_grid();
    int phase = 0;
    volatile LAS unsigned* xst = (volatile LAS unsigned*)(smem + LDS_BYTES - 16);
    if (threadIdx.x == 0) { xst[0] = 0u; xst[1] = 0u; }
    __syncthreads();
    XcdBarrier xb = xcd_barrier_post((unsigned*)(p.ws + OFF_BAR), xst);
#define WS_ (launder(p.ws))
#define H_ ((float*)(WS_ + OFF_H))
#define WB_ (WS_ + OFF_WB)
    float* H = (float*)(p.ws + OFF_H);

#define FFN_BLOCK(LAYER, SUB, FI, NSPREV) do { \
        const float* ng = p.in[2] + (size_t)(LAYER) * 3 * D + (SUB) * D; \
        for (int rep_ = 0; rep_ < NREP_NORM; ++rep_) { Ctx c = mkctx(); float* scr = (float*)(smem + c.wave * 8448); int trot = 0; \
          const float* w_in = p.in[3] + ((size_t)(LAYER) * 2 + (FI)) * (size_t)D * 2 * FF; \
          const float* w_out = p.in[4] + ((size_t)(LAYER) * 2 + (FI)) * (size_t)FF * D; \
          tr_job(w_in, D, 2 * FF, 2 * FF, nullptr, 1, (bf16_t*)(WB_ + WB_W1T), D, 0, 0, 2 * FF, D, scr, c.gw, c.ngw, c.lane, trot); \
          tr_job(w_out, FF, D, D, nullptr, 0, (bf16_t*)(WB_ + WB_W2T), LDF, 0, 0, D, FF, scr, c.gw, c.ngw, c.lane, trot); \
          if ((LAYER) == 0 && (SUB) == 0) norm_phase<1>(p, ng, H_, (bf16_t*)(WS_ + OFF_XN), c.gw, c.ngw, c.lane); \
          else norm_phase<0>(p, ng, H_, (bf16_t*)(WS_ + OFF_XN), c.gw, c.ngw, c.lane, (const float*)(WS_ + OFF_PART), NSPREV); } \
        PHASE_END(); \
        { EpiSwiGLU E; E.O = (bf16_t*)(WS_ + OFF_ACT); run_gemm(smem, (const bf16_t*)(WS_ + OFF_XN), (const bf16_t*)(WB_ + WB_W1T), 2 * FF, D, E, 0); } \
        PHASE_END(); \
        { EpiResid<((LAYER) == 1 && (SUB) == 2)> E; E.H = H_; E.scale = 0.5f; E.out = p.out; run_gemm(smem, (const bf16_t*)(WS_ + OFF_ACT), (const bf16_t*)(WB_ + WB_W2T), D, FF, E, 0, MMAIN, LDF); } \
        run_gemm_tail(smem, (const bf16_t*)(WS_ + OFF_ACT), (const bf16_t*)(WB_ + WB_W2T), FF, (float*)(WS_ + OFF_PART), 0.5f, 100, LDF); \
        PHASE_END(); } while (0)

    FFN_BLOCK(0, 0, 0, 0);
#ifndef NO_RWKV
    {
        bf16_t* Y = (bf16_t*)p.out; bf16_t* L1 = (bf16_t*)((unsigned char*)p.out + SZ_B16);
        { Ctx c = mkctx(); tail_reduce(H_, (const float*)(WS_ + OFF_PART), 11, c.bid * 512 + c.tid, c.nblk * 512); }
        xcd_barrier(xb);
        for (int rep_ = 0; rep_ < NREP_NORM; ++rep_) {
            Ctx c = mkctx(); float* scr = (float*)(smem + c.wave * 8448); int trot = 0;
            bf16_t* WPT = (bf16_t*)(WB_ + WB_WPT); bf16_t* L2W = (bf16_t*)(WB_ + WB_L2W); bf16_t* WOT = (bf16_t*)(WB_ + WB_RWO);
            const float* mix = p.in[5];
            tr_job(p.in[6], D, D, D, nullptr, 0, WPT, 2 * D, 0, 0, D, D, scr, c.gw, c.ngw, c.lane, trot);
            tr_job(p.in[6], D, D, D, mix + 0 * D, 0, WPT, 2 * D, 0, D, D, D, scr, c.gw, c.ngw, c.lane, trot);
            tr_job(p.in[7], D, D, D, nullptr, 0, WPT, 2 * D, 1024, 0, D, D, scr, c.gw, c.ngw, c.lane, trot);
            tr_job(p.in[7], D, D, D, mix + 2 * D, 0, WPT, 2 * D, 1024, D, D, D, scr, c.gw, c.ngw, c.lane, trot);
            tr_job(p.in[8], D, D, D, nullptr, 0, WPT, 2 * D, 2048, 0, D, D, scr, c.gw, c.ngw, c.lane, trot);
            tr_job(p.in[8], D, D, D, mix + 3 * D, 0, WPT, 2 * D, 2048, D, D, D, scr, c.gw, c.ngw, c.lane, trot);
            tr_job(p.in[11], D, 64, 64, nullptr, 0, WPT, 2 * D, 3072, 0, 256, D, scr, c.gw, c.ngw, c.lane, trot);
            tr_job(p.in[11], D, 64, 64, mix + 1 * D, 0, WPT, 2 * D, 3072, D, 256, D, scr, c.gw, c.ngw, c.lane, trot);
            tr_job(p.in[14], D, 64, 64, nullptr, 0, WPT, 2 * D, 3328, 0, 256, D, scr, c.gw, c.ngw, c.lane, trot);
            tr_job(p.in[14], D, 64, 64, mix + 4 * D, 0, WPT, 2 * D, 3328, D, 256, D, scr, c.gw, c.ngw, c.lane, trot);
            tr_job(p.in[16], D, 160, 160, nullptr, 0, WPT, 2 * D, 3584, 0, 256, D, scr, c.gw, c.ngw, c.lane, trot);
            tr_job(p.in[16], D, 160, 160, mix + 5 * D, 0, WPT, 2 * D, 3584, D, 256, D, scr, c.gw, c.ngw, c.lane, trot);
            tr_job(p.in[12], 64, D, D, nullptr, 0, L2W, 256, 0, 0, D, 256, scr, c.gw, c.ngw, c.lane, trot);
            tr_job(p.in[15], 64, D, D, nullptr, 0, L2W + (size_t)1024 * 256, 256, 0, 0, D, 256, scr, c.gw, c.ngw, c.lane, trot);
            tr_job(p.in[17], 160, D, D, nullptr, 0, L2W + (size_t)2 * 1024 * 256, 256, 0, 0, D, 256, scr, c.gw, c.ngw, c.lane, trot);
            tr_job(p.in[9], D, D, D, nullptr, 0, WOT, D, 0, 0, D, D, scr, c.gw, c.ngw, c.lane, trot);
            norm_phase<2>(p, p.in[2] + D, H_, (bf16_t*)(WS_ + OFF_AP), c.gw, c.ngw, c.lane);
        }
        PHASE_END();
#ifndef NO_G1
        { EpiBf<1> E; E.O0 = (bf16_t*)(WS_ + OFF_RKV); E.O1 = L1; E.bias = nullptr; E.ldo = D; run_gemm(smem, (const bf16_t*)(WS_ + OFF_AP), (const bf16_t*)(WB_ + WB_WPT), 3840, 2 * D, E, 0); }
#endif
        PHASE_END();
#ifndef NO_G23
        { EpiBf<0> E; E.O0 = (bf16_t*)(WS_ + OFF_E); E.O1 = nullptr; E.bias = nullptr; E.ldo = D; run_gemm(smem, L1, (const bf16_t*)(WB_ + WB_L2W), D, 256, E, 0); }
        { EpiBf<0> E; E.O0 = (bf16_t*)(WS_ + OFF_ASIG); E.O1 = nullptr; E.bias = nullptr; E.ldo = D; run_gemm(smem, L1 + (size_t)MP * 256, (const bf16_t*)(WB_ + WB_L2W) + (size_t)1024 * 256, D, 256, E, 64); }
#endif
        PHASE_END();
#ifndef NO_SCAN
        scan_phase(p, WS_, Y, smem);
#ifdef DUP_SCAN
        grid.sync(); scan_phase(p, WS_, Y, smem);
#endif
#endif
        PHASE_END();
        { EpiBf<0> E; E.O0 = (bf16_t*)(WS_ + OFF_E); E.O1 = nullptr; E.bias = nullptr; E.ldo = D; run_gemm(smem, L1 + (size_t)2 * MP * 256, (const bf16_t*)(WB_ + WB_L2W) + (size_t)2 * 1024 * 256, D, 256, E, 128); }
        PHASE_END();
#ifndef NO_RPOST
        { Ctx c = mkctx(); rwkv_post_phase(p, WS_, Y, c.gw, c.ngw, c.lane); }
#endif
        PHASE_END();
        { EpiResid<false> E; E.H = H_; E.scale = 1.0f; E.out = nullptr; run_gemm(smem, Y, (const bf16_t*)(WB_ + WB_RWO), D, D, E, 0, MMAIN); }
        run_gemm_tail(smem, Y, (const bf16_t*)(WB_ + WB_RWO), D, (float*)(WS_ + OFF_PART), 1.0f, 100);
        PHASE_END();
    }
#endif
    FFN_BLOCK(0, 2, 1, 4);
    FFN_BLOCK(1, 0, 0, 11);
#ifndef NO_ATTN
    {
        for (int rep_ = 0; rep_ < NREP_NORM; ++rep_) {
            Ctx c = mkctx(); float* scr = (float*)(smem + c.wave * 8448); int trot = 0;
            tr_job(p.in[23], D, 2120, 2120, nullptr, 0, (bf16_t*)(WB_ + WB_WIT), D, 0, 0, PW, D, scr, c.gw, c.ngw, c.lane, trot);
            tr_job(p.in[26], D, D, D, nullptr, 0, (bf16_t*)(WB_ + WB_AWO), D, 0, 0, D, D, scr, c.gw, c.ngw, c.lane, trot);
            rope_table_phase(p, (float*)(WS_ + OFF_TAB), c.bid * 512 + c.tid, c.nblk * 512);
            norm_phase<0>(p, p.in[2] + 3 * D + D, H_, (bf16_t*)(WS_ + OFF_HN), c.gw, c.ngw, c.lane, (const float*)(WS_ + OFF_PART), 11);
        }
        PHASE_END();
        { EpiBf<0> E; E.O0 = (bf16_t*)(WS_ + OFF_P); E.O1 = nullptr; E.bias = nullptr; E.ldo = PW; run_gemm(smem, (const bf16_t*)(WS_ + OFF_HN), (const bf16_t*)(WB_ + WB_WIT), PW, D, E, 0); }
        PHASE_END();
#ifndef NO_APOST
        { Ctx c = mkctx(); attn_post_phase(p, (bf16_t*)(WS_ + OFF_P), (const float*)(WS_ + OFF_TAB), WS_ + OFF_Q8, WS_ + OFF_K8, c.gw, c.ngw, c.lane); }
#endif
        PHASE_END();
#ifndef NO_AMAIN
        { Ctx c = mkctx(); attn_main_phase((const bf16_t*)(WS_ + OFF_P), WS_ + OFF_Q8, WS_ + OFF_K8, (bf16_t*)(WS_ + OFF_HN), smem, c.wave, c.lane, c.bid, c.nblk); }
#ifdef DUP_AMAIN
        grid.sync(); { Ctx c = mkctx(); attn_main_phase((const bf16_t*)(WS_ + OFF_P), WS_ + OFF_Q8, WS_ + OFF_K8, (bf16_t*)(WS_ + OFF_HN), smem, c.wave, c.lane, c.bid, c.nblk); }
#endif
#endif
        PHASE_END();
        { EpiResid<false> E; E.H = H_; E.scale = 1.0f; E.out = nullptr; run_gemm(smem, (const bf16_t*)(WS_ + OFF_HN), (const bf16_t*)(WB_ + WB_AWO), D, D, E, 0, MMAIN); }
        run_gemm_tail(smem, (const bf16_t*)(WS_ + OFF_HN), (const bf16_t*)(WB_ + WB_AWO), D, (float*)(WS_ + OFF_PART), 1.0f, 100);
        PHASE_END();
    }
#endif
    FFN_BLOCK(1, 2, 1, 4);
    for (int i = blockIdx.x * 512 + threadIdx.x; i < (M - MMAIN) * D / 4; i += gridDim.x * 512) {
        const int row = MMAIN + (i * 4) / D, c = (i * 4) % D, b_ = row / T, t_ = row - b_ * T;
        f32x4 v = *(const f32x4*)(H + (size_t)row * D + c);
        const float* PART = (const float*)(p.ws + OFF_PART);
        for (int s = 0; s < 11; ++s) v = v + *(const f32x4*)(PART + ((size_t)s * (M - MMAIN) + (row - MMAIN)) * D + c);
        *(f32x4*)(p.out + ((size_t)b_ * SEQ + (t_ - NMETA)) * D + c) = v;
    }
}

extern "C" void kernel_launch(void* const* d_in, const int* in_sizes, int n_in, void* d_out, int out_size, void* d_ws, size_t ws_size, hipStream_t stream) {
    static int grid_blocks = 0;
    if (!grid_blocks) {
        int dev = 0, cus = 0, per_cu = 0;
        (void)hipGetDevice(&dev);
        (void)hipDeviceGetAttribute(&cus, hipDeviceAttributeMultiprocessorCount, dev);
        if (hipFuncSetAttribute((const void*)fwd_mega, hipFuncAttributeMaxDynamicSharedMemorySize, LDS_BYTES) != hipSuccess) fprintf(stderr, "hipFuncSetAttribute failed\n");
        if (hipOccupancyMaxActiveBlocksPerMultiprocessor(&per_cu, (const void*)fwd_mega, 512, LDS_BYTES) != hipSuccess || per_cu < 1) { fprintf(stderr, "occupancy query: %d\n", per_cu); per_cu = 1; }
        (void)hipGetLastError();
        grid_blocks = cus;
        if (grid_blocks % 8) grid_blocks -= grid_blocks % 8;
        if (ws_size < ((size_t)512 << 20)) fprintf(stderr, "workspace too small: %zu\n", ws_size);
    }
    Params p{};
    for (int i = 0; i < 27; ++i) p.in[i] = (const float*)d_in[i];
    p.out = (float*)d_out; p.ws = (unsigned char*)d_ws;
    for (int i = 0; i < 8; ++i) p.inv[i] = (float)pow(500000.0, -(double)i / 8.0);
    (void)hipMemsetAsync((unsigned char*)d_ws + OFF_BAR, 0, XCD_BAR_WORDS * sizeof(unsigned), stream);
    void* args[] = {&p};
    hipError_t e = hipLaunchCooperativeKernel((const void*)fwd_mega, dim3(grid_blocks), dim3(512), args, LDS_BYTES, stream);
    if (e != hipSuccess) fprintf(stderr, "cooperative launch failed: %s (grid %d)\n", hipGetErrorString(e), grid_blocks);
}
```

```cpp
#include <hip/hip_runtime.h>
#include <hip/hip_cooperative_groups.h>
#include <cstdio>
namespace cg = cooperative_groups;
namespace pg8 {
#define PG8_LAS __attribute__((address_space(3)))
typedef unsigned short bf16_t;
typedef short bf16x8 __attribute__((ext_vector_type(8)));
typedef float f32x4 __attribute__((ext_vector_type(4)));
typedef unsigned u32x4 __attribute__((ext_vector_type(4)));
constexpr int BM = 256, BK = 64, HALF = 128, HTB = HALF * BK * 2  , STAGE_BYTES = 8 * HTB, NXCD = 8, WGM = 8;

__host__ __device__ __forceinline__ int lds_byte(int r, int c) { const int st = (r >> 4) * 2 + (c >> 5), rr = r & 15, cc = c & 31, ob = rr * 64 + cc * 2; return st * 1024 + (ob ^ (((ob >> 9) & 1) << 5)); }
__host__ __device__ __forceinline__ void stage_rc(int b, int& R, int& C) { const int st = b / 1024, sb = b % 1024, swz = sb ^ (((sb >> 9) & 1) << 5); R = (st >> 1) * 16 + swz / 64; C = (st & 1) * 32 + (swz % 64) / 2; }
__host__ __device__ __forceinline__ int perm32(int rho) { const int n = rho >> 4, i = rho & 15; return 8 * (i >> 2) + 4 * n + (i & 3); }

struct Unit { int pm, pn; };
struct Gemm { const bf16_t* A; const bf16_t* Bt; int M, N, K, ld; };

struct StaticOrder {
    int nM, nN, nwg, G, c;
    __host__ __device__ void init(int M, int N, int G_, int c_) { nM = M / BM; nN = N / BM; nwg = nM * nN; G = G_; c = c_; }
    __host__ __device__ bool next(int i, Unit& u) const {
        const long L = (long)i * G + c; if (L >= nwg) return false;
        int wgid = (int)L; { const int q = nwg / NXCD, r = nwg % NXCD, xcd = wgid % NXCD, off = wgid / NXCD; wgid = (xcd < r ? xcd * (q + 1) : r * (q + 1) + (xcd - r) * q) + off; }
        const int nig = WGM * nN, gid = wgid / nig, fm = gid * WGM, gsz = (nM - fm) < WGM ? (nM - fm) : WGM;
        u.pm = fm + ((wgid % nig) % gsz); u.pn = (wgid % nig) / gsz; return true;
    }
    __device__ __forceinline__ void a_ready(const Unit&) const {}
    __device__ __forceinline__ void done(const Unit&) const {}
    __device__ __forceinline__ size_t aoff(const Unit& u, size_t tstep) const { return (size_t)u.pm * tstep; }
    __device__ __forceinline__ size_t boff(const Unit& u, size_t tstep) const { return (size_t)u.pn * tstep; }
};
struct SplitKOrder {
    int ncol, nun, G, c;
    __device__ void init(int ncol_, int nslice, int G_, int c_) { ncol = ncol_; nun = ncol_ * nslice; G = G_; c = c_; }
    __device__ bool next(int i, Unit& u) const { const long L = (long)i * G + c; if (L >= nun) return false; u.pm = 0; u.pn = (int)L; return true; }
    __device__ __forceinline__ void a_ready(const Unit&) const {}
    __device__ __forceinline__ void done(const Unit&) const {}
    __device__ __forceinline__ size_t aoff(const Unit& u, size_t) const { return (size_t)(u.pn / ncol) * 512; }
    __device__ __forceinline__ size_t boff(const Unit& u, size_t tstep) const { return (size_t)(u.pn % ncol) * tstep + (size_t)(u.pn / ncol) * 512; }
};
__device__ __forceinline__ unsigned cvt_pk_bf16(float lo, float hi) { unsigned r; asm volatile("v_cvt_pk_bf16_f32 %0, %1, %2" : "=v"(r) : "v"(lo), "v"(hi)); return r; }

template <class Epi, class Sched, bool STAMP = false>
__device__ __forceinline__ void gemm_phase(PG8_LAS unsigned char* lds, const Gemm g, const Sched& S, const Epi& E, unsigned long long* stamps) {
    int tid_l = threadIdx.x; asm volatile("" : "+v"(tid_l));
    const int tid = tid_l, wid = __builtin_amdgcn_readfirstlane(tid >> 6), lane = tid & 63, wr = wid >> 2, wc = wid & 3, fr = lane & 15, fq = lane >> 4;
    const int K = g.K, nt = K / BK;
    int ts_lo = 0, ts_hi = 0, nts = 0; const unsigned long long rt_entry = STAMP ? (unsigned long long)wall_clock64() : 0ull;
#define PG8_STAMP() do { if (STAMP && wid == 0 && nts < 64) { const unsigned long long _c = (unsigned long long)clock64(); \
        ts_lo = (lane == nts) ? (int)(unsigned)_c : ts_lo; ts_hi = (lane == nts) ? (int)(unsigned)(_c >> 32) : ts_hi; ++nts; } } while (0)
    PG8_STAMP();
    unsigned voffA[2], voffB[2];
#pragma unroll
    for (int i = 0; i < 2; ++i) { int R, C; stage_rc(tid * 16 + i * 8192, R, C); const int Rb = Epi::PERM ? ((R & ~31) + perm32(R & 31)) : R;
        voffA[i] = (unsigned)(R * g.ld + C) * 2u; voffB[i] = (unsigned)(Rb * g.ld + C) * 2u; }
    const size_t kstep = (size_t)(BK * 2);
    const size_t hstep = (size_t)HALF * g.ld * 2;
    const size_t tstep = 2 * hstep;
    const unsigned ldsw = (unsigned)wid * 1024u;
    const int aoff = lds_byte(wr * 64 + fr, fq * 8), boff = lds_byte(wc * 32 + fr, fq * 8);
#define PG8_SA(b, h) (((b) * 2 + (h)) * HTB)
#define PG8_SB(b, h) ((4 + (b) * 2 + (h)) * HTB)
#define PG8_STAGE(bufoff, gbase, voff) do { _Pragma("unroll") for (int _i = 0; _i < 2; ++_i) \
        __builtin_amdgcn_global_load_lds((const unsigned*)((const char*)(gbase) + (voff)[_i]), (PG8_LAS unsigned*)(lds + (bufoff) + ldsw + _i * 8192), 16, 0, 0); } while (0)
#define PG8_LDA(dst, b, h) do { _Pragma("unroll") for (int m = 0; m < 4; ++m) _Pragma("unroll") for (int k = 0; k < 2; ++k) dst[m][k] = *(const PG8_LAS bf16x8*)(lds + PG8_SA(b, h) + aoff + m * 2048 + k * 1024); } while (0)
#define PG8_LDB(dst, b, h) do { _Pragma("unroll") for (int n = 0; n < 2; ++n) _Pragma("unroll") for (int k = 0; k < 2; ++k) dst[n][k] = *(const PG8_LAS bf16x8*)(lds + PG8_SB(b, h) + boff + n * 2048 + k * 1024); } while (0)
#define PG8_MMA(ai, bj, At, Bt) do { __builtin_amdgcn_s_setprio(1); _Pragma("unroll") for (int m = 0; m < 4; ++m) _Pragma("unroll") for (int n = 0; n < 2; ++n) _Pragma("unroll") for (int k = 0; k < 2; ++k) \
        acc[ai][bj][m][n] = __builtin_amdgcn_mfma_f32_16x16x32_bf16(Bt[n][k], At[m][k], acc[ai][bj][m][n], 0, 0, 0); __builtin_amdgcn_s_setprio(0); } while (0)
#define PG8_WAIT_V(n) asm volatile("s_waitcnt vmcnt(" #n ")" ::: "memory")
#define PG8_WAIT_L(n) asm volatile("s_waitcnt lgkmcnt(" #n ")" ::: "memory")
#define PG8_BAR __builtin_amdgcn_s_barrier()
#define PG8_SCHED __builtin_amdgcn_sched_barrier(0)
    Unit cur, nxt; int ui = 0;
    if (!S.next(0, cur)) return;
    f32x4 acc[2][2][4][2];
#pragma unroll
    for (int a = 0; a < 2; ++a)
#pragma unroll
        for (int b = 0; b < 2; ++b)
#pragma unroll
            for (int m = 0; m < 4; ++m)
#pragma unroll
                for (int n = 0; n < 2; ++n) acc[a][b][m][n] = (f32x4){0.f, 0.f, 0.f, 0.f};
    bf16x8 At[4][2], B0[2][2], B1[2][2];
    const char* cA = (const char*)g.A + S.aoff(cur, tstep); const char* cB = (const char*)g.Bt + S.boff(cur, tstep);
    S.a_ready(cur);
    PG8_STAGE(PG8_SB(0, 0), cB, voffB); PG8_STAGE(PG8_SA(0, 0), cA, voffA); PG8_STAGE(PG8_SB(0, 1), cB + hstep, voffB); PG8_STAGE(PG8_SA(0, 1), cA + hstep, voffA);
    if (wr == 1) PG8_BAR;
    PG8_WAIT_V(4); PG8_BAR;
    PG8_STAGE(PG8_SB(1, 0), cB + kstep, voffB); PG8_STAGE(PG8_SA(1, 0), cA + kstep, voffA); PG8_STAGE(PG8_SB(1, 1), cB + hstep + kstep, voffB);
    PG8_WAIT_V(6); PG8_BAR;
    PG8_STAMP();
    for (;;) {
        const bool has_next = S.next(ui + 1, nxt);
        const char* nA = has_next ? (const char*)g.A + S.aoff(nxt, tstep) : cA; const char* nB = has_next ? (const char*)g.Bt + S.boff(nxt, tstep) : cB;
        for (int t = 0; t < nt; t += 2) {
            const bool last = (t == nt - 2);
            const char* a1 = cA + (size_t)(t + 1) * kstep;
            const char* a2 = last ? nA : cA + (size_t)(t + 2) * kstep; const char* b2 = last ? nB : cB + (size_t)(t + 2) * kstep;
            const char* a3 = a2 + kstep; const char* b3 = b2 + kstep;
            if (last && has_next) S.a_ready(nxt);
            PG8_LDB(B0, 0, 0); PG8_SCHED; PG8_LDA(At, 0, 0); PG8_STAGE(PG8_SA(1, 1), a1 + hstep, voffA);
            PG8_WAIT_L(8); PG8_BAR; PG8_WAIT_L(0); PG8_MMA(0, 0, At, B0); PG8_BAR; PG8_SCHED;
            PG8_LDB(B1, 0, 1); PG8_STAGE(PG8_SB(0, 0), b2, voffB);
            PG8_BAR; PG8_WAIT_L(0); PG8_MMA(0, 1, At, B1); PG8_BAR;
            PG8_LDA(At, 0, 1); PG8_STAGE(PG8_SA(0, 0), a2, voffA);
            PG8_BAR; PG8_WAIT_L(0); PG8_MMA(1, 0, At, B0); PG8_BAR; PG8_SCHED;
            PG8_STAGE(PG8_SB(0, 1), b2 + hstep, voffB);
            PG8_WAIT_V(6); PG8_BAR; PG8_MMA(1, 1, At, B1); PG8_BAR;
            PG8_LDB(B0, 1, 0); PG8_SCHED; PG8_LDA(At, 1, 0); PG8_STAGE(PG8_SA(0, 1), a2 + hstep, voffA);
            PG8_WAIT_L(8); PG8_BAR; PG8_WAIT_L(0); PG8_MMA(0, 0, At, B0); PG8_BAR; PG8_SCHED;
            PG8_LDB(B1, 1, 1); PG8_STAGE(PG8_SB(1, 0), b3, voffB);
            PG8_BAR; PG8_WAIT_L(0); PG8_MMA(0, 1, At, B1); PG8_BAR;
            PG8_LDA(At, 1, 1); PG8_STAGE(PG8_SA(1, 0), a3, voffA);
            PG8_BAR; PG8_WAIT_L(0); PG8_MMA(1, 0, At, B0); PG8_BAR; PG8_SCHED;
            PG8_STAGE(PG8_SB(1, 1), b3 + hstep, voffB);
            PG8_WAIT_V(6); PG8_BAR; PG8_MMA(1, 1, At, B1); PG8_BAR;
        }
        PG8_STAMP();
        if constexpr (!Epi::AFTER_DRAIN) { E(acc, cur, wr, wc, fr, fq); S.done(cur); }
        PG8_STAMP();
        if (!has_next) break;
#pragma unroll
        for (int a = 0; a < 2; ++a)
#pragma unroll
            for (int b = 0; b < 2; ++b)
#pragma unroll
                for (int m = 0; m < 4; ++m)
#pragma unroll
                    for (int n = 0; n < 2; ++n) acc[a][b][m][n] = (f32x4){0.f, 0.f, 0.f, 0.f};
        cur = nxt; cA = nA; cB = nB; ++ui;
    }
    PG8_WAIT_V(0);
    if (wr == 0) PG8_BAR;
    PG8_BAR;
    if constexpr (Epi::AFTER_DRAIN) { E.fused(acc, cur, wr, wc, fr, fq, lds, wid, lane); S.done(cur); }
    PG8_STAMP();
    if (STAMP && wid == 0) { stamps[lane] = lane < nts ? (((unsigned long long)(unsigned)ts_hi << 32) | (unsigned)ts_lo) : 0ull;
        if (lane == 62) stamps[62] = rt_entry; if (lane == 63) stamps[63] = (unsigned long long)wall_clock64(); }
#undef PG8_STAMP
#undef PG8_SA
#undef PG8_SB
#undef PG8_STAGE
#undef PG8_LDA
#undef PG8_LDB
#undef PG8_MMA
#undef PG8_WAIT_V
#undef PG8_WAIT_L
#undef PG8_BAR
#undef PG8_SCHED
}
}
#define XB_TMO      128
#define XB_XCNT(j)  (256  + 64 * (j))
#define XB_XSUB(j)  (1280 + 64 * (j))
#define XB_XGEN(j)  (2304 + 64 * (j))
#define XB_TOP      3328
#define XB_TOPGEN   3392
#define XCD_BAR_WORDS 3456
#define XB_SPIN_CAP (1u << 18)
#ifndef LAS
#define LAS __attribute__((address_space(3)))
#endif

__device__ __forceinline__ unsigned xb_ld(unsigned* p)              { return __hip_atomic_load(p, __ATOMIC_RELAXED, __HIP_MEMORY_SCOPE_AGENT); }
__device__ __forceinline__ unsigned xb_add(unsigned* p, unsigned v) { return __hip_atomic_fetch_add(p, v, __ATOMIC_RELAXED, __HIP_MEMORY_SCOPE_AGENT); }
__device__ __forceinline__ unsigned xb_xcc_id() { return (unsigned)__builtin_amdgcn_s_getreg((3 << 11) | 20) & 0xFu; }
#define XB_SPIN(cond, bar) do { unsigned _sp = 0; while (cond) { __builtin_amdgcn_s_sleep(1); \
    if ((++_sp & 255u) == 0u) { if (xb_ld(&(bar)[XB_TMO])) break; if (_sp > XB_SPIN_CAP) { atomicAdd(&(bar)[XB_TMO], 1u); break; } } } } while (0)

struct XcdBarrier {
    unsigned* bar; unsigned x;
    volatile LAS unsigned* st;
};

__device__ __forceinline__ XcdBarrier xcd_barrier_post(unsigned* bar, volatile LAS unsigned* st) {
    XcdBarrier b; b.bar = bar; b.x = xb_xcc_id(); b.st = st;
    if (threadIdx.x == 0) (void)xb_add(&bar[XB_XCNT(b.x)], 1u);
    return b;
}
__device__ __forceinline__ void xcd_barrier_complete(unsigned* bar, unsigned x, unsigned& nloc, unsigned& nx) {
    const unsigned G = gridDim.x * gridDim.y * gridDim.z;
    unsigned sum, cnt, mine, sp = 0u;
    for (;;) {
        sum = 0u; cnt = 0u; mine = 0u;
#pragma unroll
        for (unsigned j = 0; j < 16; ++j) { const unsigned c = xb_ld(&bar[XB_XCNT(j)]); sum += c; cnt += (c > 0u) ? 1u : 0u; mine = (j == x) ? c : mine; }
        if (sum == G) break;
        __builtin_amdgcn_s_sleep(1);
        if ((++sp & 255u) == 0u) { if (xb_ld(&bar[XB_TMO])) break; if (sp > XB_SPIN_CAP) { atomicAdd(&bar[XB_TMO], 1u); break; } }
    }
    nloc = mine > 0u ? mine : 1u; nx = cnt > 0u ? cnt : 1u;
}

__device__ __forceinline__ void xcd_barrier(const XcdBarrier& b) {
    asm volatile("s_waitcnt vmcnt(0)" ::: "memory");
    __syncthreads();
    if (threadIdx.x == 0) {
        unsigned* bar = b.bar;
        __builtin_amdgcn_s_waitcnt(0);
        unsigned nloc = b.st[0], nx = b.st[1];
        if (nloc == 0u) { xcd_barrier_complete(bar, b.x, nloc, nx); b.st[0] = nloc; b.st[1] = nx; }
        const unsigned old = xb_add(&bar[XB_XSUB(b.x)], 1u);
        const unsigned gen = old / nloc;
        if (old + 1u == (gen + 1u) * nloc) {
            __builtin_amdgcn_fence(__ATOMIC_RELEASE, "agent");
            asm volatile("s_waitcnt vmcnt(0)" ::: "memory");
            const unsigned og = xb_add(&bar[XB_TOP], 1u);
            const unsigned tg = og / nx;
            if (og + 1u == (tg + 1u) * nx) xb_add(&bar[XB_TOPGEN], 1u);
            else XB_SPIN(xb_ld(&bar[XB_TOPGEN]) == tg, bar);
            __builtin_amdgcn_fence(__ATOMIC_ACQUIRE, "agent");
            xb_add(&bar[XB_XGEN(b.x)], 1u);
            asm volatile("s_waitcnt vmcnt(0)" ::: "memory");
        } else {
            XB_SPIN(xb_ld(&bar[XB_XGEN(b.x)]) == gen, bar);
            __builtin_amdgcn_fence(__ATOMIC_ACQUIRE, "agent");
            asm volatile("s_waitcnt vmcnt(0)" ::: "memory");
        }
    }
    __syncthreads();
}


using pg8::bf16_t; using pg8::f32x4; using pg8::u32x4; using pg8::bf16x8;
typedef unsigned u32x2 __attribute__((ext_vector_type(2)));

constexpr int NB = 8, T = 4112, SEQ = 4096, NMETA = 16, D = 1024, FF = 2816;
constexpr int M = NB * T;
constexpr int MP = 33024;
constexpr int MMAIN = 32768;
constexpr int LDS_BYTES = 147456;
constexpr int LDF = 2880;
constexpr int PW = 2304;
#ifndef NREP_NORM
#define NREP_NORM 1
#endif
#ifndef STOP_AFTER
#define STOP_AFTER 99
#endif

struct Params { const float* in[27]; float* out; unsigned char* ws; float inv[8]; };

constexpr size_t SZ_H = (size_t)MP * D * 4, SZ_B16 = (size_t)MP * D * 2;
constexpr size_t OFF_H = 0, OFF_WB = OFF_H + SZ_H, SZ_WB = (size_t)20 << 20, OFF_R = OFF_WB + SZ_WB;
constexpr size_t OFF_XN = OFF_R, OFF_ACT = OFF_R + SZ_B16;
constexpr size_t OFF_AP = OFF_R, OFF_E = OFF_R, OFF_ASIG = OFF_R + SZ_B16, OFF_RKV = OFF_R + 2 * SZ_B16;
constexpr size_t SZ_L1 = (size_t)MP * 256 * 2;
constexpr size_t OFF_BAR = (size_t)500 << 20;
constexpr size_t OFF_PART = (size_t)501 << 20;
constexpr size_t OFF_HN = OFF_R, OFF_P = OFF_R + SZ_B16, OFF_TAB = OFF_P + (size_t)MP * PW * 2;
constexpr size_t OFF_Q8 = OFF_TAB + ((size_t)1 << 20);
constexpr size_t OFF_K8 = OFF_Q8 + (size_t)MP * 1024;
static_assert(OFF_K8 + (size_t)MP * 256 <= OFF_BAR, "ws");
constexpr size_t WB_W1T = 0, WB_W2T = (size_t)5632 * 1024 * 2;
static_assert(WB_W2T + (size_t)1024 * LDF * 2 <= ((size_t)20 << 20), "wb");
constexpr size_t WB_WPT = 0, WB_L2W = (size_t)3840 * 2048 * 2, WB_RWO = WB_L2W + 3 * (size_t)1024 * 256 * 2;
constexpr size_t WB_WIT = 0, WB_AWO = (size_t)PW * 1024 * 2;
static_assert(OFF_RKV + 3 * SZ_B16 <= ((size_t)512 << 20), "ws");
static_assert(OFF_ACT + (size_t)MP * LDF * 2 <= ((size_t)500 << 20), "ws");
static_assert(WB_RWO + (size_t)1024 * 1024 * 2 <= SZ_WB, "wb");

__device__ __forceinline__ unsigned pk2(float a, float b) { return pg8::cvt_pk_bf16(a, b); }
__device__ __forceinline__ float bf_lo(unsigned u) { return __uint_as_float(u << 16); }
__device__ __forceinline__ float bf_hi(unsigned u) { return __uint_as_float(u & 0xffff0000u); }
__device__ __forceinline__ unsigned short f2h(float x) { _Float16 h = (_Float16)x; return __builtin_bit_cast(unsigned short, h); }
__device__ __forceinline__ float h2f(unsigned short u) { return (float)__builtin_bit_cast(_Float16, u); }
__device__ __forceinline__ void lds_wave_sync() { asm volatile("s_waitcnt lgkmcnt(0)" ::: "memory"); }
__device__ __forceinline__ float wave_sum(float v) {
#pragma unroll
    for (int o = 1; o < 64; o <<= 1) v += __shfl_xor(v, o);
    return v;
}
template <int CTRL> __device__ __forceinline__ float dppmov(float v) {
    return __builtin_bit_cast(float, __builtin_amdgcn_update_dpp(0, __builtin_bit_cast(int, v), CTRL, 0xF, 0xF, true));
}
__device__ __forceinline__ float row16_sum(float v) { v += dppmov<0xB1>(v); v += dppmov<0x4E>(v); v += dppmov<0x141>(v); v += dppmov<0x140>(v); return v; }
__device__ __forceinline__ float row16_max(float v) { v = fmaxf(v, dppmov<0xB1>(v)); v = fmaxf(v, dppmov<0x4E>(v)); v = fmaxf(v, dppmov<0x141>(v)); v = fmaxf(v, dppmov<0x140>(v)); return v; }
__device__ __forceinline__ float sigmoidf_(float x) { return 1.0f / (1.0f + __expf(-x)); }

__device__ __forceinline__ void tr_job(const float* W, int Ksrc, int Nsrc, int ldn, const float* kscale, int perm,
                                       bf16_t* WT, int ldk, int drow0, int dk0, int Npad, int Kpad, float* scr, int gw, int ngw, int lane, int& rot) {
    const int nblk = Npad / 32, nitems = (Kpad / 64) * nblk;
    const int first = (gw >= rot) ? (gw - rot) : (gw + ngw - rot);
    rot = (rot + nitems) % ngw;
    for (int it = first; it < nitems; it += ngw) {
        const int kb = it / nblk, nb = it % nblk, k0 = 64 * kb, n0 = 32 * nb;
        int ns0 = n0;
        if (perm) { const int pn = n0 >> 8, w = n0 & 255; ns0 = (w < 128) ? (128 * pn + w) : (FF + 128 * pn + (w - 128)); }
#pragma unroll
        for (int i = 0; i < 8; ++i) {
            const int kk = 8 * i + (lane >> 3), k = k0 + kk, nl = 4 * (lane & 7), n = ns0 + nl;
            f32x4 v = (f32x4){0.f, 0.f, 0.f, 0.f};
            if (k < Ksrc && n < Nsrc) { v = *(const f32x4*)(W + (size_t)k * ldn + n); if (kscale) v = v * kscale[k]; }
            float* sp = scr + kk * 33 + nl;
            sp[0] = v.x; sp[1] = v.y; sp[2] = v.z; sp[3] = v.w;
        }
        lds_wave_sync();
        const int c = lane & 7;
#pragma unroll
        for (int j = 0; j < 4; ++j) {
            const int n = (lane >> 3) + 8 * j; const float* s = scr + (8 * c) * 33 + n;
            u32x4 o; o.x = pk2(s[0 * 33], s[1 * 33]); o.y = pk2(s[2 * 33], s[3 * 33]); o.z = pk2(s[4 * 33], s[5 * 33]); o.w = pk2(s[6 * 33], s[7 * 33]);
            *(u32x4*)(WT + (size_t)(drow0 + n0 + n) * ldk + dk0 + k0 + 8 * c) = o;
        }
        lds_wave_sync();
    }
}

template <int MODE>
__device__ __forceinline__ void norm_phase(const Params& p, const float* g, float* H, bf16_t* OUT, int gw, int ngw, int lane, const float* PART = nullptr, int ns = 0) {
    constexpr int LDO = (MODE == 2) ? 2 * D : D;
    constexpr int NR = (MODE == 2) ? 2 : 4;
    f32x4 gv[4];
#pragma unroll
    for (int j = 0; j < 4; ++j) gv[j] = *(const f32x4*)(g + 4 * (lane + 64 * j));
    for (int r0 = gw; r0 < MP; r0 += NR * ngw) {
        f32x4 v[NR][4], pv[NR][4];
        int rr[NR], tt[NR];
#pragma unroll
        for (int q = 0; q < NR; ++q) {
            const int r = r0 + q * ngw; rr[q] = r;
            const int rc = (r < M) ? r : 0;
            const int b = rc / T, t = rc - b * T; tt[q] = t;
            const float* src;
            if (MODE == 1) src = (t < NMETA) ? (p.in[1] + (size_t)t * D) : (p.in[0] + ((size_t)b * SEQ + (t - NMETA)) * D);
            else src = H + (size_t)rc * D;
#pragma unroll
            for (int j = 0; j < 4; ++j) v[q][j] = *(const f32x4*)(src + 4 * (lane + 64 * j));
            if (MODE == 0 && ns > 0 && r >= MMAIN && r < M) {
                for (int s = 0; s < ns; ++s)
#pragma unroll
                    for (int j = 0; j < 4; ++j) v[q][j] = v[q][j] + *(const f32x4*)(PART + ((size_t)s * (M - MMAIN) + (r - MMAIN)) * D + 4 * (lane + 64 * j));
#pragma unroll
                for (int j = 0; j < 4; ++j) *(f32x4*)(H + (size_t)r * D + 4 * (lane + 64 * j)) = v[q][j];
            }
            if (MODE == 2) {
                const float* ps = H + (size_t)(rc > 0 ? rc - 1 : 0) * D;
#pragma unroll
                for (int j = 0; j < 4; ++j) pv[q][j] = *(const f32x4*)(ps + 4 * (lane + 64 * j));
            }
        }
#pragma unroll
        for (int q = 0; q < NR; ++q) {
            const int r = rr[q];
            if (r >= MP) continue;
            bf16_t* orow = OUT + (size_t)r * LDO;
            if (r >= M) {
#pragma unroll
                for (int j = 0; j < 4; ++j) { *(u32x2*)(orow + 4 * (lane + 64 * j)) = (u32x2){0u, 0u}; if (MODE == 2) *(u32x2*)(orow + D + 4 * (lane + 64 * j)) = (u32x2){0u, 0u}; }
                continue;
            }
            float ss = 0.f;
#pragma unroll
            for (int j = 0; j < 4; ++j) ss += v[q][j].x * v[q][j].x + v[q][j].y * v[q][j].y + v[q][j].z * v[q][j].z + v[q][j].w * v[q][j].w;
            if (MODE == 1) {
#pragma unroll
                for (int j = 0; j < 4; ++j) *(f32x4*)(H + (size_t)r * D + 4 * (lane + 64 * j)) = v[q][j];
            }
            const float rstd = 1.0f / sqrtf(wave_sum(ss) * (1.0f / D) + 1e-6f);
#pragma unroll
            for (int j = 0; j < 4; ++j) v[q][j] = v[q][j] * rstd * gv[j];
            if (MODE == 2) {
                if (tt[q] > 0) {
                    float s2 = 0.f;
#pragma unroll
                    for (int j = 0; j < 4; ++j) s2 += pv[q][j].x * pv[q][j].x + pv[q][j].y * pv[q][j].y + pv[q][j].z * pv[q][j].z + pv[q][j].w * pv[q][j].w;
                    const float rp = 1.0f / sqrtf(wave_sum(s2) * (1.0f / D) + 1e-6f);
#pragma unroll
                    for (int j = 0; j < 4; ++j) pv[q][j] = pv[q][j] * rp * gv[j];
                } else {
#pragma unroll
                    for (int j = 0; j < 4; ++j) pv[q][j] = (f32x4){0.f, 0.f, 0.f, 0.f};
                }
#pragma unroll
                for (int j = 0; j < 4; ++j) { const f32x4 xx = pv[q][j] - v[q][j]; *(u32x2*)(orow + D + 4 * (lane + 64 * j)) = (u32x2){pk2(xx.x, xx.y), pk2(xx.z, xx.w)}; }
            }
#pragma unroll
            for (int j = 0; j < 4; ++j) *(u32x2*)(orow + 4 * (lane + 64 * j)) = (u32x2){pk2(v[q][j].x, v[q][j].y), pk2(v[q][j].z, v[q][j].w)};
        }
    }
}

struct EpiSwiGLU {
    static constexpr bool PERM = true, AFTER_DRAIN = false;
    bf16_t* O;
    __device__ __forceinline__ void operator()(const f32x4 (&acc)[2][2][4][2], const pg8::Unit& u, int wr, int wc, int fr, int fq) const {
        const int row0 = u.pm * 256 + wr * 64 + fr, col0 = u.pn * 128 + wc * 32 + 8 * fq;
#pragma unroll
        for (int ai = 0; ai < 2; ++ai)
#pragma unroll
            for (int m = 0; m < 4; ++m) {
                bf16_t* rowp = O + (size_t)(row0 + ai * 128 + m * 16) * LDF + col0;
                float o[8];
#pragma unroll
                for (int n = 0; n < 2; ++n)
#pragma unroll
                    for (int j = 0; j < 4; ++j) { const float gte = acc[ai][0][m][n][j], up = acc[ai][1][m][n][j]; o[4 * n + j] = gte * __builtin_amdgcn_rcpf(1.0f + __expf(-gte)) * up; }
                u32x4 w; w.x = pk2(o[0], o[1]); w.y = pk2(o[2], o[3]); w.z = pk2(o[4], o[5]); w.w = pk2(o[6], o[7]);
                *(u32x4*)rowp = w;
            }
    }
};
template <bool FINAL> struct EpiResid {
    static constexpr bool PERM = false, AFTER_DRAIN = false;
    float* H; float scale; float* out;
    __device__ __forceinline__ void operator()(const f32x4 (&acc)[2][2][4][2], const pg8::Unit& u, int wr, int wc, int fr, int fq) const {
        const int row0 = u.pm * 256 + wr * 64 + fr, col0 = u.pn * 256 + wc * 32 + 4 * fq;
#pragma unroll
        for (int ai = 0; ai < 2; ++ai)
#pragma unroll
            for (int m = 0; m < 4; ++m) {
                const int row = row0 + ai * 128 + m * 16;
                if (row < M) {
                    float* hp = H + (size_t)row * D + col0;
                    const int b = row / T, t = row - b * T;
                    float* op = FINAL ? (out + ((size_t)b * SEQ + (t - NMETA)) * D + col0) : nullptr;
#pragma unroll
                    for (int bj = 0; bj < 2; ++bj)
#pragma unroll
                        for (int n = 0; n < 2; ++n) {
                            f32x4 hv = *(const f32x4*)(hp + bj * 128 + n * 16); hv = hv + acc[ai][bj][m][n] * scale;
                            if (FINAL) { if (t >= NMETA) *(f32x4*)(op + bj * 128 + n * 16) = hv; }
                            else *(f32x4*)(hp + bj * 128 + n * 16) = hv;
                        }
                }
            }
    }
};
template <int mode> struct EpiBf {
    static constexpr bool PERM = true, AFTER_DRAIN = false;
    bf16_t* O0; bf16_t* O1; const float* bias; int ldo;
    template <int ACT> __device__ __forceinline__ void body(const f32x4 (&acc)[2][2][4][2], bf16_t* base, int ld, int row0, int col0) const {
#pragma unroll
        for (int ai = 0; ai < 2; ++ai)
#pragma unroll
            for (int m = 0; m < 4; ++m)
#pragma unroll
                for (int bj = 0; bj < 2; ++bj) {
                    bf16_t* rowp = base + (size_t)(row0 + ai * 128 + m * 16) * ld + col0 + bj * 128;
                    f32x4 v0 = acc[ai][bj][m][0] + (f32x4){0.f, 0.f, 0.f, 0.f}, v1 = acc[ai][bj][m][1] + (f32x4){0.f, 0.f, 0.f, 0.f};
                    if (mode >= 2) { v0 = v0 + *(const f32x4*)(bias + col0 + bj * 128); v1 = v1 + *(const f32x4*)(bias + col0 + bj * 128 + 4); }
#pragma unroll
                    for (int j = 0; j < 4; ++j) {
                        if (ACT == 1) { v0[j] = 1.0f - 2.0f / (__expf(2.0f * v0[j]) + 1.0f); v1[j] = 1.0f - 2.0f / (__expf(2.0f * v1[j]) + 1.0f); }
                        if (ACT == 2) { v0[j] = sigmoidf_(v0[j]); v1[j] = sigmoidf_(v1[j]); }
                        if (ACT == 3) { v0[j] = 0.6065306597f * sigmoidf_(v0[j]); v1[j] = 0.6065306597f * sigmoidf_(v1[j]); }
                    }
                    u32x4 w;
#ifdef PKRTZ
                    if (ACT == 3) { typedef _Float16 h2_ __attribute__((ext_vector_type(2))); h2_ q0 = __builtin_amdgcn_cvt_pkrtz(v0[0], v0[1]), q1 = __builtin_amdgcn_cvt_pkrtz(v0[2], v0[3]), q2 = __builtin_amdgcn_cvt_pkrtz(v1[0], v1[1]), q3 = __builtin_amdgcn_cvt_pkrtz(v1[2], v1[3]);
                        w.x = __builtin_bit_cast(unsigned, q0); w.y = __builtin_bit_cast(unsigned, q1); w.z = __builtin_bit_cast(unsigned, q2); w.w = __builtin_bit_cast(unsigned, q3); } else
#endif
                    if (ACT == 3) {
                        w.x = f2h(v0[0]) | ((unsigned)f2h(v0[1]) << 16); w.y = f2h(v0[2]) | ((unsigned)f2h(v0[3]) << 16);
                        w.z = f2h(v1[0]) | ((unsigned)f2h(v1[1]) << 16); w.w = f2h(v1[2]) | ((unsigned)f2h(v1[3]) << 16);
                    } else { w.x = pk2(v0[0], v0[1]); w.y = pk2(v0[2], v0[3]); w.z = pk2(v1[0], v1[1]); w.w = pk2(v1[2], v1[3]); }
                    *(u32x4*)rowp = w;
                }
    }
    __device__ __forceinline__ void operator()(const f32x4 (&acc)[2][2][4][2], const pg8::Unit& u, int wr, int wc, int fr, int fq) const {
        const int row0 = u.pm * 256 + wr * 64 + fr, cl = wc * 32 + 8 * fq;
        if (mode == 1) {
            if (u.pn < 12) body<0>(acc, O0 + (size_t)(u.pn >> 2) * ((size_t)MP * D), D, row0, (u.pn & 3) * 256 + cl);
            else if (u.pn == 12) body<1>(acc, O1, 256, row0, cl);
            else if (u.pn == 13) body<0>(acc, O1 + (size_t)MP * 256, 256, row0, cl);
            else body<2>(acc, O1 + (size_t)2 * MP * 256, 256, row0, cl);
        } else if (mode == 2) body<3>(acc, O0, ldo, row0, u.pn * 256 + cl);
        else if (mode == 3) body<2>(acc, O0, ldo, row0, u.pn * 256 + cl);
        else body<0>(acc, O0, ldo, row0, u.pn * 256 + cl);
    }
};

template <class Epi>
__device__ __forceinline__ void run_gemm(unsigned char* smem, const bf16_t* A, const bf16_t* Bt, int N, int K, const Epi E, int rot, int Mrows = MP, int ld = 0) {
    pg8::Gemm g; g.A = A; g.Bt = Bt; g.M = Mrows; g.N = N; g.K = K; g.ld = ld ? ld : K;
    pg8::StaticOrder S; S.init(Mrows, N, (int)gridDim.x, (int)((blockIdx.x + rot) % gridDim.x));
    pg8::gemm_phase<Epi, pg8::StaticOrder, false>((PG8_LAS unsigned char*)smem, g, S, E, nullptr);
    __syncthreads();
}

struct EpiTailPart {
    static constexpr bool PERM = false, AFTER_DRAIN = false;
    float* PART; float scale;
    __device__ __forceinline__ void operator()(const f32x4 (&acc)[2][2][4][2], const pg8::Unit& u, int wr, int wc, int fr, int fq) const {
        const int lrow0 = wr * 64 + fr, col0 = (u.pn & 3) * 256 + wc * 32 + 4 * fq;
        float* base = PART + (size_t)(u.pn >> 2) * ((size_t)(M - MMAIN) * D);
#pragma unroll
        for (int m = 0; m < 4; ++m) {
            const int lrow = lrow0 + m * 16;
            if (lrow < M - MMAIN) {
                float* hp = base + (size_t)lrow * D + col0;
#pragma unroll
                for (int bj = 0; bj < 2; ++bj)
#pragma unroll
                    for (int n = 0; n < 2; ++n) *(f32x4*)(hp + bj * 128 + n * 16) = acc[0][bj][m][n] * scale;
            }
        }
    }
};
__device__ __forceinline__ void run_gemm_tail(unsigned char* smem, const bf16_t* A, const bf16_t* Bt, int K, float* PART, float scale, int rot, int ld = 0) {
    if (!ld) ld = K;
    pg8::Gemm g; g.A = A + (size_t)MMAIN * ld; g.Bt = Bt; g.M = 256; g.N = D; g.K = 256; g.ld = ld;
    pg8::SplitKOrder S; S.init(4, K / 256, (int)gridDim.x, (int)((blockIdx.x + rot) % gridDim.x));
    EpiTailPart E; E.PART = PART; E.scale = scale;
    pg8::gemm_phase<EpiTailPart, pg8::SplitKOrder, false>((PG8_LAS unsigned char*)smem, g, S, E, nullptr);
    __syncthreads();
}

constexpr int SC_STEP = 356, SC_TC = 32;
__device__ __forceinline__ void scan_phase(const Params& p, unsigned char* ws, bf16_t* Y, unsigned char* smem) {
    float* buf = (float*)smem;
    float* ybuf = (float*)(smem + 2 * SC_TC * SC_STEP * 4);
    const bf16_t* Rr = (const bf16_t*)(ws + OFF_RKV); const bf16_t* Kr = Rr + (size_t)MP * D; const bf16_t* Vr = Kr + (size_t)MP * D;
    const bf16_t* As = (const bf16_t*)(ws + OFF_ASIG); const bf16_t* Eh = (const bf16_t*)(ws + OFF_E);
    int tid = threadIdx.x; asm volatile("" : "+v"(tid));
    const bool is_comp = tid < 256;
    const int sub = tid & 15, grp = (tid >> 4) & 15;
    constexpr int NCH = (T + SC_TC - 1) / SC_TC;
    typedef float f32x2_ __attribute__((ext_vector_type(2)));
    for (int item = blockIdx.x; item < 256; item += gridDim.x) {
        const int b = item >> 5, h = (item >> 1) & 15, half = item & 1;
        const int cb = h * 64 + 4 * sub;
        f32x4 kkc, kac, w0c, a0c;
        if (!is_comp) { kkc = *(const f32x4*)(p.in[18] + cb); kac = *(const f32x4*)(p.in[19] + cb); w0c = *(const f32x4*)(p.in[10] + cb); a0c = *(const f32x4*)(p.in[13] + cb); }
        auto stage2 = [&](int c, float* dstb) {
            u32x2 pr[2], pk[2], pa[2], pe[2], pv[2];
#pragma unroll
            for (int q = 0; q < 2; ++q) {
                const int t = c * SC_TC + grp + 16 * q;
                pr[q] = (u32x2){0u, 0u}; pk[q] = pr[q]; pa[q] = pr[q]; pe[q] = pr[q]; pv[q] = pr[q];
                if (t < T) {
                    const size_t ro = ((size_t)b * T + t) * D;
                    pr[q] = *(const u32x2*)(Rr + ro + cb); pk[q] = *(const u32x2*)(Kr + ro + cb); pa[q] = *(const u32x2*)(As + ro + cb); pe[q] = *(const u32x2*)(Eh + ro + cb);
                    if (sub < 8) pv[q] = *(const u32x2*)(Vr + ro + h * 64 + half * 32 + 4 * sub);
                }
            }
#pragma unroll
            for (int q = 0; q < 2; ++q) {
                float* sp = dstb + (grp + 16 * q) * SC_STEP;
                const f32x4 r4 = (f32x4){bf_lo(pr[q].x), bf_hi(pr[q].x), bf_lo(pr[q].y), bf_hi(pr[q].y)};
                const f32x4 k4 = (f32x4){bf_lo(pk[q].x), bf_hi(pk[q].x), bf_lo(pk[q].y), bf_hi(pk[q].y)};
                f32x4 a4 = (f32x4){bf_lo(pa[q].x), bf_hi(pa[q].x), bf_lo(pa[q].y), bf_hi(pa[q].y)} + a0c;
                a4.x = sigmoidf_(a4.x); a4.y = sigmoidf_(a4.y); a4.z = sigmoidf_(a4.z); a4.w = sigmoidf_(a4.w);
                f32x4 e4 = (f32x4){bf_lo(pe[q].x), bf_hi(pe[q].x), bf_lo(pe[q].y), bf_hi(pe[q].y)} + w0c;
                e4.x = 0.6065306597f * sigmoidf_(e4.x); e4.y = 0.6065306597f * sigmoidf_(e4.y); e4.z = 0.6065306597f * sigmoidf_(e4.z); e4.w = 0.6065306597f * sigmoidf_(e4.w);
                f32x4 kk = k4 * kkc;
                const float ss = row16_sum(kk.x * kk.x + kk.y * kk.y + kk.z * kk.z + kk.w * kk.w);
                const float inv = 1.0f / fmaxf(sqrtf(ss), 1e-12f);
                kk = kk * inv;
                const f32x4 kf = k4 * (1.0f + (a4 - 1.0f) * kac);
                f32x4 w; w.x = __expf(-e4.x); w.y = __expf(-e4.y); w.z = __expf(-e4.z); w.w = __expf(-e4.w);
                const f32x4 Bv = kk * a4, WR = w * r4;
                const float br = row16_sum(Bv.x * r4.x + Bv.y * r4.y + Bv.z * r4.z + Bv.w * r4.w);
                const float kr = row16_sum(kf.x * r4.x + kf.y * r4.y + kf.z * r4.z + kf.w * r4.w);
                *(f32x4*)(sp + 4 * sub) = -kk; *(f32x4*)(sp + 64 + 4 * sub) = WR; *(f32x4*)(sp + 128 + 4 * sub) = w; *(f32x4*)(sp + 192 + 4 * sub) = Bv; *(f32x4*)(sp + 256 + 4 * sub) = kf;
                if (sub < 8) *(f32x4*)(sp + 320 + 4 * sub) = (f32x4){bf_lo(pv[q].x), bf_hi(pv[q].x), bf_lo(pv[q].y), bf_hi(pv[q].y)};
                if (sub == 0) { sp[352] = br; sp[353] = kr; }
            }
        };
        auto yout = [&](int c) {
            const int st = (tid - 256) >> 3, r4i = (tid & 7) * 4, t = c * SC_TC + st;
            if (t < T) {
                const f32x4 yv = *(const f32x4*)(ybuf + (c & 1) * (SC_TC * 32) + st * 32 + r4i);
                *(u32x2*)(Y + ((size_t)b * T + t) * D + h * 64 + half * 32 + r4i) = (u32x2){pk2(yv.x, yv.y), pk2(yv.z, yv.w)};
            }
        };
        if (!is_comp) stage2(0, buf);
        __syncthreads();
        f32x2_ Sa01 = (f32x2_){0.f, 0.f}, Sa23 = Sa01, Sb01 = Sa01, Sb23 = Sa01;
        for (int c = 0; c < NCH; ++c) {
            if (is_comp) {
                const int nst = (T - c * SC_TC) < SC_TC ? (T - c * SC_TC) : SC_TC;
                const float* cbuf = buf + (c & 1) * (SC_TC * SC_STEP); float* yb = ybuf + (c & 1) * (SC_TC * 32);
#define SC_LDO(X, s_) do { const float* sp_ = cbuf + (s_) * SC_STEP; \
                    A4##X = *(const f32x4*)(sp_ + 4 * sub); WR4##X = *(const f32x4*)(sp_ + 64 + 4 * sub); W4##X = *(const f32x4*)(sp_ + 128 + 4 * sub); \
                    B4##X = *(const f32x4*)(sp_ + 192 + 4 * sub); K4##X = *(const f32x4*)(sp_ + 256 + 4 * sub); \
                    via##X = sp_[320 + grp]; vib##X = sp_[336 + grp]; bk##X = *(const f32x2_*)(sp_ + 352); } while (0)
#define SC_STEPF(X, s_) do { \
                    const f32x2_ A01 = (f32x2_){A4##X.x, A4##X.y}, A23 = (f32x2_){A4##X.z, A4##X.w}, R01 = (f32x2_){WR4##X.x, WR4##X.y}, R23 = (f32x2_){WR4##X.z, WR4##X.w}; \
                    const f32x2_ sa2 = Sa01 * A01 + Sa23 * A23, sb2 = Sb01 * A01 + Sb23 * A23; \
                    const f32x2_ ya2 = Sa01 * R01 + Sa23 * R23, yb2 = Sb01 * R01 + Sb23 * R23; \
                    const float sa = row16_sum(sa2.x + sa2.y), sb = row16_sum(sb2.x + sb2.y), ypa = row16_sum(ya2.x + ya2.y), ypb = row16_sum(yb2.x + yb2.y); \
                    const f32x2_ W01 = (f32x2_){W4##X.x, W4##X.y}, W23 = (f32x2_){W4##X.z, W4##X.w}, B01 = (f32x2_){B4##X.x, B4##X.y}, B23 = (f32x2_){B4##X.z, B4##X.w}, K01 = (f32x2_){K4##X.x, K4##X.y}, K23 = (f32x2_){K4##X.z, K4##X.w}; \
                    const f32x2_ sav = (f32x2_){sa, sa}, sbv = (f32x2_){sb, sb}, vav = (f32x2_){via##X, via##X}, vbv = (f32x2_){vib##X, vib##X}; \
                    Sa01 = Sa01 * W01 + (sav * B01 + vav * K01); Sa23 = Sa23 * W23 + (sav * B23 + vav * K23); \
                    Sb01 = Sb01 * W01 + (sbv * B01 + vbv * K01); Sb23 = Sb23 * W23 + (sbv * B23 + vbv * K23); \
                    if (sub == 0) { yb[(s_) * 32 + grp] = ypa + sa * bk##X.x + via##X * bk##X.y; yb[(s_) * 32 + 16 + grp] = ypb + sb * bk##X.x + vib##X * bk##X.y; } } while (0)
                f32x4 A4a, WR4a, W4a, B4a, K4a, A4b, WR4b, W4b, B4b, K4b; float viaa, viba, viab, vibb; f32x2_ bka, bkb;
                SC_LDO(a, 0);
                for (int s = 0; s < nst; s += 2) {
                    SC_LDO(b, s + 1);
                    SC_STEPF(a, s);
                    if (s + 2 < nst) SC_LDO(a, s + 2);
                    SC_STEPF(b, s + 1);
                }
            } else {
                if (c > 0) yout(c - 1);
                if (c + 1 < NCH) stage2(c + 1, buf + ((c + 1) & 1) * (SC_TC * SC_STEP));
            }
            __syncthreads();
        }
        if (!is_comp) yout(NCH - 1);
        __syncthreads();
    }
}

__device__ __forceinline__ float red8_sum(float v) { v += dppmov<0xB1>(v); v += dppmov<0x4E>(v); v += dppmov<0x141>(v); return v; }
__device__ __forceinline__ void unpack8(const u32x4 u, float (&f)[8]) {
    f[0] = bf_lo(u.x); f[1] = bf_hi(u.x); f[2] = bf_lo(u.y); f[3] = bf_hi(u.y); f[4] = bf_lo(u.z); f[5] = bf_hi(u.z); f[6] = bf_lo(u.w); f[7] = bf_hi(u.w);
}
__device__ __forceinline__ void ld8f(const float* p, float (&f)[8]) { const f32x4 a = *(const f32x4*)p, b = *(const f32x4*)(p + 4); f[0] = a.x; f[1] = a.y; f[2] = a.z; f[3] = a.w; f[4] = b.x; f[5] = b.y; f[6] = b.z; f[7] = b.w; }
__device__ __forceinline__ void rwkv_post_phase(const Params& p, unsigned char* ws, bf16_t* Y, int gw, int ngw, int lane) {
    const bf16_t* Rr = (const bf16_t*)(ws + OFF_RKV); const bf16_t* Kr = Rr + (size_t)MP * D; const bf16_t* Vr = Kr + (size_t)MP * D;
    const bf16_t* As = (const bf16_t*)(ws + OFF_ASIG); const bf16_t* G = (const bf16_t*)(ws + OFF_E);
    const int grp = lane >> 3, s8 = lane & 7;
    constexpr int NI = 2;
    for (int w0 = gw; w0 < MP * 2; w0 += NI * ngw) {
        u32x4 uy[NI], ur[NI], uk[NI], uv[NI], ua[NI], ug[NI]; size_t os[NI]; int c0s[NI], st[NI];
#pragma unroll
        for (int i = 0; i < NI; ++i) {
            const int w = w0 + i * ngw, wc = (w < MP * 2) ? w : w0;
            const int row = wc >> 1, oct = wc & 1; c0s[i] = (oct * 8 + grp) * 64 + 8 * s8; os[i] = (size_t)row * D + c0s[i];
            st[i] = (w >= MP * 2) ? 2 : ((row >= M) ? 1 : 0);
            const size_t o = (row >= M) ? (size_t)c0s[i] : os[i];
            uy[i] = *(const u32x4*)(Y + o); ur[i] = *(const u32x4*)(Rr + o); uk[i] = *(const u32x4*)(Kr + o); uv[i] = *(const u32x4*)(Vr + o); ua[i] = *(const u32x4*)(As + o); ug[i] = *(const u32x4*)(G + o);
        }
#pragma unroll
        for (int i = 0; i < NI; ++i) {
            const int c0 = c0s[i];
            float y[8], r[8], k[8], v[8], a[8], g[8], a0[8], kac[8], rkc[8], lg[8], lb[8];
            unpack8(uy[i], y); unpack8(ur[i], r); unpack8(uk[i], k); unpack8(uv[i], v); unpack8(ua[i], a); unpack8(ug[i], g);
            ld8f(p.in[13] + c0, a0); ld8f(p.in[19] + c0, kac); ld8f(p.in[20] + c0, rkc); ld8f(p.in[21] + c0, lg); ld8f(p.in[22] + c0, lb);
            float t3 = 0.f, sy = 0.f;
#pragma unroll
            for (int e = 0; e < 8; ++e) { const float as = sigmoidf_(a[e] + a0[e]); const float kf = k[e] * (1.0f + (as - 1.0f) * kac[e]); t3 += r[e] * kf * rkc[e]; sy += y[e]; }
            const float rk = red8_sum(t3);
            const float mu = red8_sum(sy) * (1.0f / 64.0f);
            float sv = 0.f;
#pragma unroll
            for (int e = 0; e < 8; ++e) { y[e] -= mu; sv += y[e] * y[e]; }
            const float var = red8_sum(sv) * (1.0f / 64.0f);
            const float rs = 1.0f / sqrtf(var + 64e-5f);
            float z[8];
#pragma unroll
            for (int e = 0; e < 8; ++e) z[e] = ((y[e] * rs) * lg[e] + lb[e] + v[e] * rk) * g[e];
            if (st[i] == 0) *(u32x4*)(Y + os[i]) = (u32x4){pk2(z[0], z[1]), pk2(z[2], z[3]), pk2(z[4], z[5]), pk2(z[6], z[7])};
            else if (st[i] == 1) *(u32x4*)(Y + os[i]) = (u32x4){0u, 0u, 0u, 0u};
        }
    }
}

__device__ __forceinline__ void rope_table_phase(const Params& p, float* TAB, int gtid, int ngt) {
    for (int i = gtid; i < T * 8; i += ngt) {
        const int t = i >> 3, k = i & 7;
        const float ang = (float)t * p.inv[k];
        double rev = (double)ang * 0.15915494309189535; rev -= rint(rev);
        const float rf = (float)rev;
        TAB[t * 16 + k] = __builtin_amdgcn_cosf(rf); TAB[t * 16 + 8 + k] = __builtin_amdgcn_sinf(rf);
    }
}
__device__ __forceinline__ void attn_post_phase(const Params& p, bf16_t* P, const float* TAB, unsigned char* Q8, unsigned char* K8, int gw, int ngw, int lane) {
    const int grp = lane >> 4, sub = lane & 15;
    const f32x4 qg = *(const f32x4*)(p.in[24] + 4 * sub), kg = *(const f32x4*)(p.in[25] + 4 * sub);
    constexpr int NI = 8;
    for (int w0 = gw; w0 < M * 8; w0 += NI * ngw) {
        u32x2 raw[NI]; bf16_t* ptrs[NI]; int us[NI], ts[NI];
#pragma unroll
        for (int i = 0; i < NI; ++i) {
            const int w = w0 + i * ngw, wc = (w < M * 8) ? w : w0;
            const int row = wc >> 3; int q4 = wc & 7; if (q4 >= 5) q4 += 1;
            us[i] = (w < M * 8) ? (4 * q4 + grp) : 99; ts[i] = row % T;
            ptrs[i] = P + (size_t)row * PW + 64 * (4 * q4 + grp) + 4 * sub;
            raw[i] = *(const u32x2*)ptrs[i];
        }
#pragma unroll
        for (int i = 0; i < NI; ++i) {
            const int u = us[i], t = ts[i];
            f32x4 x = (f32x4){bf_lo(raw[i].x), bf_hi(raw[i].x), bf_lo(raw[i].y), bf_hi(raw[i].y)};
            const bool isq = u < 16, isk = (u >= 16) && (u < 20), dorope = (u < 20) || (u >= 24 && u <= 32);
            const float ss = row16_sum(x.x * x.x + x.y * x.y + x.z * x.z + x.w * x.w) * (1.0f / 64.0f);
            if (isq || isk) { const float rs = 1.0f / sqrtf(ss + 1e-6f); x = x * rs * (isq ? qg : kg); }
            f32x4 xp; xp.x = dppmov<0x4E>(x.x); xp.y = dppmov<0x4E>(x.y); xp.z = dppmov<0x4E>(x.z); xp.w = dppmov<0x4E>(x.w);
            if (dorope && sub < 4) {
                const float* tb = TAB + t * 16 + (sub & 1) * 4;
                const f32x4 c = *(const f32x4*)tb, s = *(const f32x4*)(tb + 8);
                x = (sub < 2) ? (x * c - xp * s) : (x * c + xp * s);
            }
            if (u == 33) { if (sub < 2) x = x * 0.04419417382f; }
            if (u < 34) *(u32x2*)ptrs[i] = (u32x2){pk2(x.x, x.y), pk2(x.z, x.w)};
            if (u < 20) {
                int w8 = __builtin_amdgcn_cvt_pk_fp8_f32(x.x, x.y, 0, false); w8 = __builtin_amdgcn_cvt_pk_fp8_f32(x.z, x.w, w8, true);
                const size_t row_ = (size_t)(ptrs[i] - P) / PW;
                if (u < 16) *(int*)(Q8 + row_ * 1024 + u * 64 + 4 * sub) = w8; else *(int*)(K8 + row_ * 256 + (u - 16) * 64 + 4 * sub) = w8;
            }
        }
    }
}

constexpr int AT_WAVE_LDS = 16448 + 512;
__device__ __forceinline__ void attn_main_phase(const bf16_t* P, const unsigned char* Q8, const unsigned char* K8, bf16_t* AO, unsigned char* smem, int wave, int lane_in, int bid, int nblk) {
    float* sc = (float*)(smem + wave * AT_WAVE_LDS);
    unsigned short* idxl = (unsigned short*)(smem + wave * AT_WAVE_LDS + 16448);
    const int b = bid & 7;
    const float NEG_INF = -__builtin_huge_valf();
    const bf16_t* pb = P + (size_t)b * T * PW;
    for (int ug = (bid >> 3); ug < T / 8; ug += (nblk >> 3)) {
        int lane = lane_in; asm volatile("" : "+v"(lane));
        const int n15 = lane & 15, kq = lane >> 4;
        const int t0 = ug * 8, t = t0 + wave;
        const size_t row = (size_t)b * T + t;
        const bf16_t* prow = P + row * PW;
        int nsel;
        if (t0 >= 256) {
            nsel = 256;
            bf16x8 ia[4][2]; float w4[4][4];
#pragma unroll
            for (int mt = 0; mt < 4; ++mt) {
                const bf16_t* qp = pb + (size_t)(t0 + 2 * mt + (n15 >> 3)) * PW + 1536 + (n15 & 7) * 64 + kq * 8;
                ia[mt][0] = *(const bf16x8*)qp; ia[mt][1] = *(const bf16x8*)(qp + 32);
                const u32x2 wr = *(const u32x2*)(pb + (size_t)(t0 + 2 * mt + (kq >> 1)) * PW + 2112 + 4 * (kq & 1));
                w4[mt][0] = bf_lo(wr.x); w4[mt][1] = bf_hi(wr.x); w4[mt][2] = bf_lo(wr.y); w4[mt][3] = bf_hi(wr.y);
            }
            const int ntb = ((t0 + 7) >> 4) + 1;
            auto ldk = [&](bf16x8& d0, bf16x8& d1, int kt) { const bf16_t* kb = pb + (size_t)(16 * kt + n15) * PW + 2048 + kq * 8; d0 = *(const bf16x8*)kb; d1 = *(const bf16x8*)(kb + 32); };
            auto cmp = [&](const bf16x8& d0, const bf16x8& d1, int kt) {
#pragma unroll
                for (int mt = 0; mt < 4; ++mt) {
                    f32x4 acc = (f32x4){0.f, 0.f, 0.f, 0.f};
                    acc = __builtin_amdgcn_mfma_f32_16x16x32_bf16(ia[mt][0], d0, acc, 0, 0, 0);
                    acc = __builtin_amdgcn_mfma_f32_16x16x32_bf16(ia[mt][1], d1, acc, 0, 0, 0);
                    float ps = w4[mt][0] * fmaxf(acc[0], 0.f) + w4[mt][1] * fmaxf(acc[1], 0.f) + w4[mt][2] * fmaxf(acc[2], 0.f) + w4[mt][3] * fmaxf(acc[3], 0.f);
                    ps += __shfl_xor(ps, 16);
                    if ((kq & 1) == 0) ((float*)(smem + (2 * mt + (kq >> 1)) * AT_WAVE_LDS))[16 * kt + n15] = ps;
                }
            };
            bf16x8 xa0, xa1, xb0, xb1, xc0, xc1, xd0, xd1;
            int kt = wave;
            if (kt < ntb) ldk(xa0, xa1, kt);
            if (kt + 8 < ntb) ldk(xb0, xb1, kt + 8);
            if (kt + 16 < ntb) ldk(xc0, xc1, kt + 16);
            for (; kt < ntb; kt += 32) {
                if (kt + 24 < ntb) ldk(xd0, xd1, kt + 24);
                cmp(xa0, xa1, kt);
                if (kt + 32 < ntb) ldk(xa0, xa1, kt + 32);
                if (kt + 8 < ntb) cmp(xb0, xb1, kt + 8);
                if (kt + 40 < ntb) ldk(xb0, xb1, kt + 40);
                if (kt + 16 < ntb) cmp(xc0, xc1, kt + 16);
                if (kt + 48 < ntb) ldk(xc0, xc1, kt + 48);
                if (kt + 24 < ntb) cmp(xd0, xd1, kt + 24);
            }
            __syncthreads();
            unsigned key[65];
#pragma unroll
            for (int r = 0; r < 65; ++r) {
                const int e = r * 64 + lane;
                unsigned uu = __float_as_uint(sc[e]);
                if (uu == 0x80000000u) uu = 0u;
                uu = (uu & 0x80000000u) ? ~uu : (uu | 0x80000000u);
                key[r] = (e <= t) ? uu : 0u;
            }
            unsigned Tk = 0u;
            for (int bit = 31; bit >= 16; --bit) {
                const unsigned cand = Tk | (1u << bit);
                int cnt = 0;
#pragma unroll
                for (int gi = 0; gi < 5; ++gi) {
                    if (gi * 832 <= t) {
#pragma unroll
                        for (int rr = 0; rr < 13; ++rr) cnt += __popcll(__ballot(key[gi * 13 + rr] >= cand));
                    }
                }
                if (cnt >= 256) Tk = cand;
            }
            {
                const unsigned up = Tk + 0x10000u, hsel = Tk >> 16;
                int c_hi = 0, nc = 0;
                unsigned* cl = (unsigned*)sc;
                lds_wave_sync();
#pragma unroll
                for (int r = 0; r < 65; ++r) {
                    const bool hi = (up != 0u) && (key[r] >= up), cd = (key[r] >> 16) == hsel;
                    c_hi += __popcll(__ballot(hi));
                    const unsigned long long mc = __ballot(cd);
                    const int pos = nc + (int)__builtin_amdgcn_mbcnt_hi((unsigned)(mc >> 32), __builtin_amdgcn_mbcnt_lo((unsigned)mc, 0u));
                    if (cd) cl[pos] = key[r] & 0xffffu;
                    nc += __popcll(mc);
                }
                lds_wave_sync();
                const int nch = (nc + 63) >> 6;
                unsigned L = 0u;
                for (int bit = 15; bit >= 0; --bit) {
                    const unsigned cand = L | (1u << bit);
                    int cnt = c_hi;
                    for (int i = 0; i < nch; ++i) { const int ix = i * 64 + lane; const unsigned v = cl[ix]; cnt += __popcll(__ballot((ix < nc) && (v >= cand))); }
                    if (cnt >= 256) L = cand;
                }
                Tk |= L;
            }
            int ngt = 0;
#pragma unroll
            for (int r = 0; r < 65; ++r) ngt += __popcll(__ballot(key[r] > Tk));
            const int need = 256 - ngt;
            lds_wave_sync();
            int pg = 0, pe = 0;
#pragma unroll
            for (int r = 0; r < 65; ++r) {
                const int e = r * 64 + lane;
                const bool gt = key[r] > Tk, eq = key[r] == Tk;
                const unsigned long long mg = __ballot(gt), me = __ballot(eq);
                const int og = pg + (int)__builtin_amdgcn_mbcnt_hi((unsigned)(mg >> 32), __builtin_amdgcn_mbcnt_lo((unsigned)mg, 0u));
                const int oe = pe + (int)__builtin_amdgcn_mbcnt_hi((unsigned)(me >> 32), __builtin_amdgcn_mbcnt_lo((unsigned)me, 0u));
                if (gt) idxl[og] = (unsigned short)e;
                if (eq && oe < need) idxl[ngt + oe] = (unsigned short)e;
                pg += __popcll(mg); pe += __popcll(me);
            }
        } else {
            nsel = t + 1;
#pragma unroll
            for (int j = 0; j < 4; ++j) { const int e = j * 64 + lane; idxl[e] = (unsigned short)(e < t ? e : t); }
        }
        lds_wave_sync();
        const int ntile = (nsel + 15) >> 4;
        typedef long l2_ __attribute__((ext_vector_type(2)));
        const l2_ qv = *(const l2_*)(Q8 + row * 1024 + n15 * 64 + kq * 16);
        const unsigned char* pk8 = K8 + (size_t)b * T * 256;
        f32x4 mx4 = (f32x4){NEG_INF, NEG_INF, NEG_INF, NEG_INF};
        {
            auto ldt = [&](l2_ (&d)[4], int kt) {
                const int krow = idxl[16 * kt + n15];
                const unsigned char* kb = pk8 + (size_t)krow * 256 + kq * 16;
#pragma unroll
                for (int g = 0; g < 4; ++g) d[g] = *(const l2_*)(kb + 64 * g);
            };
            auto cmt = [&](const l2_ (&d)[4], int kt) {
                const int j = 16 * kt + n15;
                f32x4 a0 = (f32x4){0.f, 0.f, 0.f, 0.f}, a1 = a0, a2 = a0, a3 = a0;
                a0 = __builtin_amdgcn_mfma_f32_16x16x32_fp8_fp8(qv.x, d[0].x, a0, 0, 0, 0); a0 = __builtin_amdgcn_mfma_f32_16x16x32_fp8_fp8(qv.y, d[0].y, a0, 0, 0, 0);
                a1 = __builtin_amdgcn_mfma_f32_16x16x32_fp8_fp8(qv.x, d[1].x, a1, 0, 0, 0); a1 = __builtin_amdgcn_mfma_f32_16x16x32_fp8_fp8(qv.y, d[1].y, a1, 0, 0, 0);
                a2 = __builtin_amdgcn_mfma_f32_16x16x32_fp8_fp8(qv.x, d[2].x, a2, 0, 0, 0); a2 = __builtin_amdgcn_mfma_f32_16x16x32_fp8_fp8(qv.y, d[2].y, a2, 0, 0, 0);
                a3 = __builtin_amdgcn_mfma_f32_16x16x32_fp8_fp8(qv.x, d[3].x, a3, 0, 0, 0); a3 = __builtin_amdgcn_mfma_f32_16x16x32_fp8_fp8(qv.y, d[3].y, a3, 0, 0, 0);
                f32x4 sel = (kq == 0) ? a0 : ((kq == 1) ? a1 : ((kq == 2) ? a2 : a3));
#pragma unroll
                for (int r = 0; r < 4; ++r) { sel[r] = (j < nsel) ? sel[r] * 0.125f : NEG_INF; mx4[r] = fmaxf(mx4[r], sel[r]); }
                *(f32x4*)(sc + j * 16 + 4 * kq) = sel;
            };
            l2_ ka[4], kb2[4], kc[4];
            ldt(ka, 0);
            if (1 < ntile) ldt(kb2, 1);
            for (int kt = 0; kt < ntile; kt += 3) {
                if (kt + 2 < ntile) ldt(kc, kt + 2);
                cmt(ka, kt);
                if (kt + 1 < ntile) { if (kt + 3 < ntile) ldt(ka, kt + 3); cmt(kb2, kt + 1); }
                if (kt + 2 < ntile) { if (kt + 4 < ntile) ldt(kb2, kt + 4); cmt(kc, kt + 2); }
            }
        }
#pragma unroll
        for (int r = 0; r < 4; ++r) mx4[r] = row16_max(mx4[r]);
        f32x4 sm4 = (f32x4){0.f, 0.f, 0.f, 0.f};
        for (int kt = 0; kt < ntile; ++kt) {
            float* pp = sc + (16 * kt + n15) * 16 + 4 * kq;
            f32x4 v = *(const f32x4*)pp;
#pragma unroll
            for (int r = 0; r < 4; ++r) { v[r] = __expf(v[r] - mx4[r]); sm4[r] += v[r]; }
            *(f32x4*)pp = v;
        }
#pragma unroll
        for (int r = 0; r < 4; ++r) sm4[r] = 1.0f / row16_sum(sm4[r]);
        float* invl = sc + 4096;
        if (n15 == 0) *(f32x4*)(invl + 4 * kq) = sm4;
        lds_wave_sync();
        const int kp = lane >> 5, pg = (lane >> 3) & 3, d8 = lane & 7;
        typedef float f32x2p __attribute__((ext_vector_type(2)));
        f32x2p o[4][4];
#pragma unroll
        for (int hh = 0; hh < 4; ++hh)
#pragma unroll
            for (int e = 0; e < 4; ++e) o[hh][e] = (f32x2p){0.f, 0.f};
        {
            auto ldv = [&](u32x4 (&d)[4], int jp0) {
#pragma unroll
                for (int i = 0; i < 4; ++i) {
                    const int krow = idxl[2 * (jp0 + i) + kp];
                    d[i] = *(const u32x4*)(pb + (size_t)krow * PW + 1280 + pg * 64 + d8 * 8);
                }
            };
            auto cmv = [&](const u32x4 (&d)[4], int jp0) {
#pragma unroll
                for (int i = 0; i < 4; ++i) {
                    const int j = 2 * (jp0 + i) + kp;
                    const f32x4 p4 = *(const f32x4*)(sc + j * 16 + 4 * pg);
                    const f32x2p v[4] = {(f32x2p){bf_lo(d[i].x), bf_hi(d[i].x)}, (f32x2p){bf_lo(d[i].y), bf_hi(d[i].y)}, (f32x2p){bf_lo(d[i].z), bf_hi(d[i].z)}, (f32x2p){bf_lo(d[i].w), bf_hi(d[i].w)}};
#pragma unroll
                    for (int hh = 0; hh < 4; ++hh) {
                        const f32x2p ps = (f32x2p){p4[hh], p4[hh]};
#pragma unroll
                        for (int e = 0; e < 4; ++e) o[hh][e] = o[hh][e] + ps * v[e];
                    }
                }
            };
            u32x4 va[4], vb2[4];
            const int npairs = 8 * ntile;
            ldv(va, 0);
            for (int c0 = 0; c0 < npairs; c0 += 8) {
                ldv(vb2, c0 + 4);
                cmv(va, c0);
                if (c0 + 8 < npairs) ldv(va, c0 + 8);
                cmv(vb2, c0 + 4);
            }
        }
        {
            const f32x4 iv = *(const f32x4*)(invl + 4 * pg);
#pragma unroll
            for (int hh = 0; hh < 4; ++hh) {
                float r[8];
#pragma unroll
                for (int e = 0; e < 4; ++e) { r[2 * e] = (o[hh][e].x + __shfl_xor(o[hh][e].x, 32)) * iv[hh]; r[2 * e + 1] = (o[hh][e].y + __shfl_xor(o[hh][e].y, 32)) * iv[hh]; }
                if (lane < 32) *(u32x4*)(AO + row * D + (4 * pg + hh) * 64 + 8 * d8) = (u32x4){pk2(r[0], r[1]), pk2(r[2], r[3]), pk2(r[4], r[5]), pk2(r[6], r[7])};
            }
        }
        __syncthreads();
    }
}

__device__ __forceinline__ void tail_reduce(float* H, const float* PART, int ns, int gtid, int ngt) {
    for (int i = gtid; i < (M - MMAIN) * D / 4; i += ngt) {
        f32x4 v = *(const f32x4*)(H + (size_t)MMAIN * D + (size_t)i * 4);
        for (int s = 0; s < ns; ++s) v = v + *(const f32x4*)(PART + (size_t)s * ((size_t)(M - MMAIN) * D) + (size_t)i * 4);
        *(f32x4*)(H + (size_t)MMAIN * D + (size_t)i * 4) = v;
    }
}

struct Ctx { int tid, lane, wave, gw, ngw, bid, nblk; };
__device__ __forceinline__ Ctx mkctx() {
    int tid = threadIdx.x, bid = blockIdx.x, nb = gridDim.x;
    asm volatile("" : "+v"(tid)); asm volatile("" : "+s"(bid)); asm volatile("" : "+s"(nb));
    Ctx c; c.tid = tid; c.lane = tid & 63; c.wave = __builtin_amdgcn_readfirstlane(tid >> 6); c.bid = bid; c.nblk = nb; c.gw = bid * 8 + c.wave; c.ngw = nb * 8; return c;
}
template <class T_> __device__ __forceinline__ T_* launder(T_* ptr) { return ptr; }

#ifdef DUP_SYNC
#define EXTRA_SYNC() grid.sync()
#else
#define EXTRA_SYNC()
#endif
#define PHASE_END() do { if (phase == 0) grid.sync(); else xcd_barrier(xb); EXTRA_SYNC(); ++phase; if (STOP_AFTER == phase) { dump_h(p, H); return; } } while (0)
__device__ __forceinline__ void dump_h(const Params& p, const float* H) {
    for (size_t i = (size_t)blockIdx.x * 512 + threadIdx.x; i < (size_t)NB * SEQ * D / 4; i += (size_t)gridDim.x * 512) {
        const size_t e = i * 4, orow = e / D, c = e % D, b_ = orow / SEQ, t_ = orow % SEQ; *(f32x4*)(p.out + e) = *(const f32x4*)(H + ((size_t)b_ * T + t_ + NMETA) * D + c); }
}

__global__ void __launch_bounds__(512, 2) fwd_mega(Params p) {
    extern __shared__ __attribute__((aligned(16))) unsigned char smem[];
    cg::grid_group grid = cg::this_grid();
    int phase = 0;
    volatile LAS unsigned* xst = (volatile LAS unsigned*)(smem + LDS_BYTES - 16);
    if (threadIdx.x == 0) { xst[0] = 0u; xst[1] = 0u; }
    __syncthreads();
    XcdBarrier xb = xcd_barrier_post((unsigned*)(p.ws + OFF_BAR), xst);
#define WS_ (launder(p.ws))
#define H_ ((float*)(WS_ + OFF_H))
#define WB_ (WS_ + OFF_WB)
    float* H = (float*)(p.ws + OFF_H);

#define FFN_BLOCK(LAYER, SUB, FI, NSPREV) do { \
        const float* ng = p.in[2] + (size_t)(LAYER) * 3 * D + (SUB) * D; \
        for (int rep_ = 0; rep_ < NREP_NORM; ++rep_) { Ctx c = mkctx(); float* scr = (float*)(smem + c.wave * 8448); int trot = 0; \
          const float* w_in = p.in[3] + ((size_t)(LAYER) * 2 + (FI)) * (size_t)D * 2 * FF; \
          const float* w_out = p.in[4] + ((size_t)(LAYER) * 2 + (FI)) * (size_t)FF * D; \
          tr_job(w_in, D, 2 * FF, 2 * FF, nullptr, 1, (bf16_t*)(WB_ + WB_W1T), D, 0, 0, 2 * FF, D, scr, c.gw, c.ngw, c.lane, trot); \
          tr_job(w_out, FF, D, D, nullptr, 0, (bf16_t*)(WB_ + WB_W2T), LDF, 0, 0, D, FF, scr, c.gw, c.ngw, c.lane, trot); \
          if ((LAYER) == 0 && (SUB) == 0) norm_phase<1>(p, ng, H_, (bf16_t*)(WS_ + OFF_XN), c.gw, c.ngw, c.lane); \
          else norm_phase<0>(p, ng, H_, (bf16_t*)(WS_ + OFF_XN), c.gw, c.ngw, c.lane, (const float*)(WS_ + OFF_PART), NSPREV); } \
        PHASE_END(); \
        { EpiSwiGLU E; E.O = (bf16_t*)(WS_ + OFF_ACT); run_gemm(smem, (const bf16_t*)(WS_ + OFF_XN), (const bf16_t*)(WB_ + WB_W1T), 2 * FF, D, E, 0); } \
        PHASE_END(); \
        { EpiResid<((LAYER) == 1 && (SUB) == 2)> E; E.H = H_; E.scale = 0.5f; E.out = p.out; run_gemm(smem, (const bf16_t*)(WS_ + OFF_ACT), (const bf16_t*)(WB_ + WB_W2T), D, FF, E, 0, MMAIN, LDF); } \
        run_gemm_tail(smem, (const bf16_t*)(WS_ + OFF_ACT), (const bf16_t*)(WB_ + WB_W2T), FF, (float*)(WS_ + OFF_PART), 0.5f, 100, LDF); \
        PHASE_END(); } while (0)

    FFN_BLOCK(0, 0, 0, 0);
#ifndef NO_RWKV
    {
        bf16_t* Y = (bf16_t*)p.out; bf16_t* L1 = (bf16_t*)((unsigned char*)p.out + SZ_B16);
        { Ctx c = mkctx(); tail_reduce(H_, (const float*)(WS_ + OFF_PART), 11, c.bid * 512 + c.tid, c.nblk * 512); }
        xcd_barrier(xb);
        for (int rep_ = 0; rep_ < NREP_NORM; ++rep_) {
            Ctx c = mkctx(); float* scr = (float*)(smem + c.wave * 8448); int trot = 0;
            bf16_t* WPT = (bf16_t*)(WB_ + WB_WPT); bf16_t* L2W = (bf16_t*)(WB_ + WB_L2W); bf16_t* WOT = (bf16_t*)(WB_ + WB_RWO);
            const float* mix = p.in[5];
            tr_job(p.in[6], D, D, D, nullptr, 0, WPT, 2 * D, 0, 0, D, D, scr, c.gw, c.ngw, c.lane, trot);
            tr_job(p.in[6], D, D, D, mix + 0 * D, 0, WPT, 2 * D, 0, D, D, D, scr, c.gw, c.ngw, c.lane, trot);
            tr_job(p.in[7], D, D, D, nullptr, 0, WPT, 2 * D, 1024, 0, D, D, scr, c.gw, c.ngw, c.lane, trot);
            tr_job(p.in[7], D, D, D, mix + 2 * D, 0, WPT, 2 * D, 1024, D, D, D, scr, c.gw, c.ngw, c.lane, trot);
            tr_job(p.in[8], D, D, D, nullptr, 0, WPT, 2 * D, 2048, 0, D, D, scr, c.gw, c.ngw, c.lane, trot);
            tr_job(p.in[8], D, D, D, mix + 3 * D, 0, WPT, 2 * D, 2048, D, D, D, scr, c.gw, c.ngw, c.lane, trot);
            tr_job(p.in[11], D, 64, 64, nullptr, 0, WPT, 2 * D, 3072, 0, 256, D, scr, c.gw, c.ngw, c.lane, trot);
            tr_job(p.in[11], D, 64, 64, mix + 1 * D, 0, WPT, 2 * D, 3072, D, 256, D, scr, c.gw, c.ngw, c.lane, trot);
            tr_job(p.in[14], D, 64, 64, nullptr, 0, WPT, 2 * D, 3328, 0, 256, D, scr, c.gw, c.ngw, c.lane, trot);
            tr_job(p.in[14], D, 64, 64, mix + 4 * D, 0, WPT, 2 * D, 3328, D, 256, D, scr, c.gw, c.ngw, c.lane, trot);
            tr_job(p.in[16], D, 160, 160, nullptr, 0, WPT, 2 * D, 3584, 0, 256, D, scr, c.gw, c.ngw, c.lane, trot);
            tr_job(p.in[16], D, 160, 160, mix + 5 * D, 0, WPT, 2 * D, 3584, D, 256, D, scr, c.gw, c.ngw, c.lane, trot);
            tr_job(p.in[12], 64, D, D, nullptr, 0, L2W, 256, 0, 0, D, 256, scr, c.gw, c.ngw, c.lane, trot);
            tr_job(p.in[15], 64, D, D, nullptr, 0, L2W + (size_t)1024 * 256, 256, 0, 0, D, 256, scr, c.gw, c.ngw, c.lane, trot);
            tr_job(p.in[17], 160, D, D, nullptr, 0, L2W + (size_t)2 * 1024 * 256, 256, 0, 0, D, 256, scr, c.gw, c.ngw, c.lane, trot);
            tr_job(p.in[9], D, D, D, nullptr, 0, WOT, D, 0, 0, D, D, scr, c.gw, c.ngw, c.lane, trot);
            norm_phase<2>(p, p.in[2] + D, H_, (bf16_t*)(WS_ + OFF_AP), c.gw, c.ngw, c.lane);
        }
        PHASE_END();
#ifndef NO_G1
        { EpiBf<1> E; E.O0 = (bf16_t*)(WS_ + OFF_RKV); E.O1 = L1; E.bias = nullptr; E.ldo = D; run_gemm(smem, (const bf16_t*)(WS_ + OFF_AP), (const bf16_t*)(WB_ + WB_WPT), 3840, 2 * D, E, 0); }
#endif
        PHASE_END();
#ifndef NO_G23
        { EpiBf<0> E; E.O0 = (bf16_t*)(WS_ + OFF_E); E.O1 = nullptr; E.bias = nullptr; E.ldo = D; run_gemm(smem, L1, (const bf16_t*)(WB_ + WB_L2W), D, 256, E, 0); }
        { EpiBf<0> E; E.O0 = (bf16_t*)(WS_ + OFF_ASIG); E.O1 = nullptr; E.bias = nullptr; E.ldo = D; run_gemm(smem, L1 + (size_t)MP * 256, (const bf16_t*)(WB_ + WB_L2W) + (size_t)1024 * 256, D, 256, E, 64); }
#endif
        PHASE_END();
#ifndef NO_SCAN
        scan_phase(p, WS_, Y, smem);
#ifdef DUP_SCAN
        grid.sync(); scan_phase(p, WS_, Y, smem);
#endif
#endif
        PHASE_END();
        { EpiBf<0> E; E.O0 = (bf16_t*)(WS_ + OFF_E); E.O1 = nullptr; E.bias = nullptr; E.ldo = D; run_gemm(smem, L1 + (size_t)2 * MP * 256, (const bf16_t*)(WB_ + WB_L2W) + (size_t)2 * 1024 * 256, D, 256, E, 128); }
        PHASE_END();
#ifndef NO_RPOST
        { Ctx c = mkctx(); rwkv_post_phase(p, WS_, Y, c.gw, c.ngw, c.lane); }
#endif
        PHASE_END();
        { EpiResid<false> E; E.H = H_; E.scale = 1.0f; E.out = nullptr; run_gemm(smem, Y, (const bf16_t*)(WB_ + WB_RWO), D, D, E, 0, MMAIN); }
        run_gemm_tail(smem, Y, (const bf16_t*)(WB_ + WB_RWO), D, (float*)(WS_ + OFF_PART), 1.0f, 100);
        PHASE_END();
    }
#endif
    FFN_BLOCK(0, 2, 1, 4);
    FFN_BLOCK(1, 0, 0, 11);
#ifndef NO_ATTN
    {
        for (int rep_ = 0; rep_ < NREP_NORM; ++rep_) {
            Ctx c = mkctx(); float* scr = (float*)(smem + c.wave * 8448); int trot = 0;
            tr_job(p.in[23], D, 2120, 2120, nullptr, 0, (bf16_t*)(WB_ + WB_WIT), D, 0, 0, PW, D, scr, c.gw, c.ngw, c.lane, trot);
            tr_job(p.in[26], D, D, D, nullptr, 0, (bf16_t*)(WB_ + WB_AWO), D, 0, 0, D, D, scr, c.gw, c.ngw, c.lane, trot);
            rope_table_phase(p, (float*)(WS_ + OFF_TAB), c.bid * 512 + c.tid, c.nblk * 512);
            norm_phase<0>(p, p.in[2] + 3 * D + D, H_, (bf16_t*)(WS_ + OFF_HN), c.gw, c.ngw, c.lane, (const float*)(WS_ + OFF_PART), 11);
        }
        PHASE_END();
        { EpiBf<0> E; E.O0 = (bf16_t*)(WS_ + OFF_P); E.O1 = nullptr; E.bias = nullptr; E.ldo = PW; run_gemm(smem, (const bf16_t*)(WS_ + OFF_HN), (const bf16_t*)(WB_ + WB_WIT), PW, D, E, 0); }
        PHASE_END();
#ifndef NO_APOST
        { Ctx c = mkctx(); attn_post_phase(p, (bf16_t*)(WS_ + OFF_P), (const float*)(WS_ + OFF_TAB), WS_ + OFF_Q8, WS_ + OFF_K8, c.gw, c.ngw, c.lane); }
#endif
        PHASE_END();
#ifndef NO_AMAIN
        { Ctx c = mkctx(); attn_main_phase((const bf16_t*)(WS_ + OFF_P), WS_ + OFF_Q8, WS_ + OFF_K8, (bf16_t*)(WS_ + OFF_HN), smem, c.wave, c.lane, c.bid, c.nblk); }
#ifdef DUP_AMAIN
        grid.sync(); { Ctx c = mkctx(); attn_main_phase((const bf16_t*)(WS_ + OFF_P), WS_ + OFF_Q8, WS_ + OFF_K8, (bf16_t*)(WS_ + OFF_HN), smem, c.wave, c.lane, c.bid, c.nblk); }
#endif
#endif
        PHASE_END();
        { EpiResid<false> E; E.H = H_; E.scale = 1.0f; E.out = nullptr; run_gemm(smem, (const bf16_t*)(WS_ + OFF_HN), (const bf16_t*)(WB_ + WB_AWO), D, D, E, 0, MMAIN); }
        run_gemm_tail(smem, (const bf16_t*)(WS_ + OFF_HN), (const bf16_t*)(WB_ + WB_AWO), D, (float*)(WS_ + OFF_PART), 1.0f, 100);
        PHASE_END();
    }
#endif
    FFN_BLOCK(1, 2, 1, 4);
    for (int i = blockIdx.x * 512 + threadIdx.x; i < (M - MMAIN) * D / 4; i += gridDim.x * 512) {
        const int row = MMAIN + (i * 4) / D, c = (i * 4) % D, b_ = row / T, t_ = row - b_ * T;
        f32x4 v = *(const f32x4*)(H + (size_t)row * D + c);
        const float* PART = (const float*)(p.ws + OFF_PART);
        for (int s = 0; s < 11; ++s) v = v + *(const f32x4*)(PART + ((size_t)s * (M - MMAIN) + (row - MMAIN)) * D + c);
        *(f32x4*)(p.out + ((size_t)b_ * SEQ + (t_ - NMETA)) * D + c) = v;
    }
}

extern "C" void kernel_launch(void* const* d_in, const int* in_sizes, int n_in, void* d_out, int out_size, void* d_ws, size_t ws_size, hipStream_t stream) {
    static int grid_blocks = 0;
    if (!grid_blocks) {
        int dev = 0, cus = 0, per_cu = 0;
        (void)hipGetDevice(&dev);
        (void)hipDeviceGetAttribute(&cus, hipDeviceAttributeMultiprocessorCount, dev);
        if (hipFuncSetAttribute((const void*)fwd_mega, hipFuncAttributeMaxDynamicSharedMemorySize, LDS_BYTES) != hipSuccess) fprintf(stderr, "hipFuncSetAttribute failed\n");
        if (hipOccupancyMaxActiveBlocksPerMultiprocessor(&per_cu, (const void*)fwd_mega, 512, LDS_BYTES) != hipSuccess || per_cu < 1) { fprintf(stderr, "occupancy query: %d\n", per_cu); per_cu = 1; }
        (void)hipGetLastError();
        grid_blocks = cus;
        if (grid_blocks % 8) grid_blocks -= grid_blocks % 8;
        if (ws_size < ((size_t)512 << 20)) fprintf(stderr, "workspace too small: %zu\n", ws_size);
    }
    Params p{};
    for (int i = 0; i < 27; ++i) p.in[i] = (const float*)d_in[i];
    p.out = (float*)d_out; p.ws = (unsigned char*)d_ws;
    for (int i = 0; i < 8; ++i) p.inv[i] = (float)pow(500000.0, -(double)i / 8.0);
    (void)hipMemsetAsync((unsigned char*)d_ws + OFF_BAR, 0, XCD_BAR_WORDS * sizeof(unsigned), stream);
    void* args[] = {&p};
    hipError_t e = hipLaunchCooperativeKernel((const void*)fwd_mega, dim3(grid_blocks), dim3(512), args, LDS_BYTES, stream);
    if (e != hipSuccess) fprintf(stderr, "cooperative launch failed: %s (grid %d)\n", hipGetErrorString(e), grid_blocks);
}
```
